# Optimizing an MI355X kernel written in HIP

```python
import math
import jax, jax.numpy as jnp
from jax import lax
import numpy as np

D_MODEL = 1024
BATCH = 32
SEQ = 2048
DEPTH = 2
DEC_BATCH = 8
DEC_SEQ = 2048
PAST_LEN = 128

GRID_W = 64
HEAD_DIM = 64
QBLK = 128
ROPE_THETA = 10000.0
EPS = 1e-6
N_BRANCH = 4
A_HEADS = 4
A_D = HEAD_DIM // 2
A_VD = HEAD_DIM
B_HEADS = 4
B_D = HEAD_DIM
WIN_R = 8
WIN_C = 16
B_QCB = WIN_C
B_KCB = 2 * WIN_C
C_HEADS = 4
C_NOPE = 64
C_ROPE = 32
C_VD = 64
C_QLORA = 192
C_KVLORA = 128
D_HEADS = 4
D_KV_HEADS = 2
D_D = HEAD_DIM
D_GROUP = D_HEADS // D_KV_HEADS
BRANCH_W = 256
A_QK_COLS = A_HEADS * 2 * A_D
A_COLS = 2 * A_QK_COLS + A_HEADS * A_VD
B_COLS = 3 * B_HEADS * B_D
C_COLS = C_QLORA + C_KVLORA + C_ROPE
D_COLS = (D_HEADS + 2 * D_KV_HEADS) * D_D
GATE_COLS = N_BRANCH * D_MODEL
IN_COLS = A_COLS + B_COLS + C_COLS + D_COLS + GATE_COLS
FFN_DIM = 2816
CONV_W = 3

kernel_name = "hybrid_gated_parallel_encoder"


def rmsnorm(x, g):
    x32 = x.astype(jnp.float32)
    y = x32 * lax.rsqrt(jnp.mean(x32 * x32, axis=-1, keepdims=True) + EPS)
    return (y * g.astype(jnp.float32)).astype(x.dtype)


def rope_angles(pos, dim):
    inv_freq = ROPE_THETA ** (-jnp.arange(0, dim, 2, dtype=jnp.float32) / dim)
    return pos.astype(jnp.float32)[:, None] * inv_freq[None, :]


def apply_rope(x, ang):
    half = x.shape[-1] // 2
    shape = (1, ang.shape[0]) + (1,) * (x.ndim - 3) + (half,)
    cos = jnp.cos(ang).reshape(shape).astype(x.dtype)
    sin = jnp.sin(ang).reshape(shape).astype(x.dtype)
    x1, x2 = x[..., :half], x[..., half:]
    return jnp.concatenate([x1 * cos - x2 * sin, x2 * cos + x1 * sin], axis=-1)


def axial_rope(x, ang_row, ang_col):
    half = x.shape[-1] // 2
    return jnp.concatenate([apply_rope(x[..., :half], ang_row), apply_rope(x[..., half:], ang_col)], axis=-1)


def to_query_blocks(a):
    b, s = a.shape[:2]
    a = a.reshape((b, s // QBLK, QBLK) + a.shape[2:])
    return jnp.moveaxis(a, 1, 0)


def from_query_blocks(o):
    o = jnp.moveaxis(o, 0, 1)
    return o.reshape((o.shape[0], o.shape[1] * o.shape[2]) + o.shape[3:])


def diff_mixer(cols, ang, lq1, lk1, lq2, lk2, subln, lam_init):
    b, s, _ = cols.shape
    f32 = jnp.float32
    q, k, v = jnp.split(cols, [A_QK_COLS, 2 * A_QK_COLS], axis=-1)
    q = apply_rope(q.reshape(b, s, A_HEADS, 2, A_D), ang) * (A_D ** -0.5)
    k = apply_rope(k.reshape(b, s, A_HEADS, 2, A_D), ang)
    v = v.reshape(b, s, A_HEADS, A_VD)
    lam = (jnp.exp(jnp.sum(lq1.astype(f32) * lk1.astype(f32)))
           - jnp.exp(jnp.sum(lq2.astype(f32) * lk2.astype(f32))) + lam_init)

    def block(qb):
        sc = jnp.einsum('bqhcd,bkhcd->bhcqk', qb, k).astype(f32)
        p = jax.nn.softmax(sc, axis=-1)
        w = (p[:, :, 0] - lam * p[:, :, 1]).astype(v.dtype)
        return jnp.einsum('bhqk,bkhd->bqhd', w, v)

    o = from_query_blocks(lax.map(block, to_query_blocks(q)))
    o = rmsnorm(o, subln) * (1.0 - lam_init)
    return o.reshape(b, s, A_HEADS * A_VD)


def natten_mixer(cols, rpb):
    b, s, _ = cols.shape
    hd = B_HEADS * B_D
    q, k, v = jnp.split(cols, [hd, 2 * hd], axis=-1)
    rows = s // GRID_W
    wr = min(WIN_R, rows)
    ncb = GRID_W // B_QCB
    qg = (q * (B_D ** -0.5)).reshape(b, rows, ncb, B_QCB, B_HEADS, B_D)
    kg = k.reshape(b, rows, GRID_W, B_HEADS, B_D)
    vg = v.reshape(b, rows, GRID_W, B_HEADS, B_D)
    cb = np.clip(np.arange(ncb) * B_QCB - WIN_C // 2, 0, GRID_W - B_KCB)
    col_idx = cb[:, None] + np.arange(B_KCB)
    qcol = np.arange(GRID_W).reshape(ncb, B_QCB)
    cs = np.clip(qcol - WIN_C // 2, 0, GRID_W - WIN_C)
    kc = col_idx[:, None, :]
    col_mask = (kc >= cs[..., None]) & (kc < cs[..., None] + WIN_C)
    dc_idx = np.clip(kc - qcol[..., None] + WIN_C - 1, 0, 2 * WIN_C - 2)
    n_keys = wr * B_KCB
    mask = np.broadcast_to(col_mask[:, :, None, :], (ncb, B_QCB, wr, B_KCB)).reshape(ncb, B_QCB, n_keys)
    mask = jnp.asarray(mask)
    dc_b = jnp.asarray(dc_idx[:, :, None, :])

    def row_block(r):
        rs = jnp.clip(r - wr // 2, 0, rows - wr)
        k_blk = lax.dynamic_slice_in_dim(kg, rs, wr, axis=1)[:, :, col_idx]
        v_blk = lax.dynamic_slice_in_dim(vg, rs, wr, axis=1)[:, :, col_idx]
        k_blk = jnp.moveaxis(k_blk, 1, 2).reshape(b, ncb, n_keys, B_HEADS, B_D)
        v_blk = jnp.moveaxis(v_blk, 1, 2).reshape(b, ncb, n_keys, B_HEADS, B_D)
        q_blk = lax.dynamic_index_in_dim(qg, r, axis=1, keepdims=False)
        sc = jnp.einsum('bnqhd,bnlhd->bhnql', q_blk, k_blk).astype(jnp.float32)
        dr_idx = rs + jnp.arange(wr) - r + WIN_R - 1
        bias = rpb[:, dr_idx[None, None, :, None], dc_b]
        bias = bias.reshape(B_HEADS, ncb, B_QCB, n_keys).astype(jnp.float32)
        p = jax.nn.softmax(jnp.where(mask, sc + bias, -jnp.inf), axis=-1)
        o = jnp.einsum('bhnql,bnlhd->bnqhd', p.astype(v_blk.dtype), v_blk)
        return o.reshape(b, GRID_W, B_HEADS, B_D)

    out = lax.map(row_block, jnp.arange(rows))
    return jnp.moveaxis(out, 0, 1).reshape(b, s, hd)


def mla_mixer(cols, ang, q_norm, kv_norm, w_uq, w_ukv):
    b, s, _ = cols.shape
    cq, ckv, k_rope = jnp.split(cols, [C_QLORA, C_QLORA + C_KVLORA], axis=-1)
    q = (rmsnorm(cq, q_norm) @ w_uq).reshape(b, s, C_HEADS, C_NOPE + C_ROPE)
    q = jnp.concatenate([q[..., :C_NOPE], apply_rope(q[..., C_NOPE:], ang)], axis=-1)
    q = q * ((C_NOPE + C_ROPE) ** -0.5)
    kv = (rmsnorm(ckv, kv_norm) @ w_ukv).reshape(b, s, C_HEADS, C_NOPE + C_VD)
    k_nope, v = kv[..., :C_NOPE], kv[..., C_NOPE:]
    k_rope = apply_rope(k_rope, ang)[:, :, None, :]
    k = jnp.concatenate([k_nope, jnp.broadcast_to(k_rope, (b, s, C_HEADS, C_ROPE))], axis=-1)

    def block(qb):
        sc = jnp.einsum('bqhd,bkhd->bhqk', qb, k).astype(jnp.float32)
        p = jax.nn.softmax(sc, axis=-1).astype(v.dtype)
        return jnp.einsum('bhqk,bkhd->bqhd', p, v)

    o = from_query_blocks(lax.map(block, to_query_blocks(q)))
    return o.reshape(b, s, C_HEADS * C_VD)


def gqa_mixer(cols, ang_row, ang_col, q_norm, k_norm):
    b, s, _ = cols.shape
    qd = D_HEADS * D_D
    kvd = D_KV_HEADS * D_D
    q, k, v = jnp.split(cols, [qd, qd + kvd], axis=-1)
    q = axial_rope(rmsnorm(q.reshape(b, s, D_KV_HEADS, D_GROUP, D_D), q_norm), ang_row, ang_col) * (D_D ** -0.5)
    k = axial_rope(rmsnorm(k.reshape(b, s, D_KV_HEADS, D_D), k_norm), ang_row, ang_col)
    v = v.reshape(b, s, D_KV_HEADS, D_D)

    def block(qb):
        sc = jnp.einsum('bqngd,bknd->bngqk', qb, k).astype(jnp.float32)
        p = jax.nn.softmax(sc, axis=-1).astype(v.dtype)
        return jnp.einsum('bngqk,bknd->bqngd', p, v)

    o = from_query_blocks(lax.map(block, to_query_blocks(q)))
    return o.reshape(b, s, qd)


def conv_ffn(h, w_in, conv_w, conv_b, w_out):
    ug = h @ w_in
    u, g = ug[..., :FFN_DIM], ug[..., FFN_DIM:]
    gp = jnp.pad(g, ((0, 0), (1, 1), (0, 0)))
    g = gp[:, :-2] * conv_w[0] + gp[:, 1:-1] * conv_w[1] + gp[:, 2:] * conv_w[2] + conv_b
    return (jax.nn.silu(g) * u) @ w_out


def encoder_trunk(x, attn_norm, w_in, a_lambda_q1, a_lambda_k1, a_lambda_q2, a_lambda_k2, a_subln,
                  b_rpb, c_q_norm, c_kv_norm, c_w_uq, c_w_ukv, d_q_norm, d_k_norm,
                  w_branch, w_out, ffn_norm, w_ffn_in, ffn_conv_w, ffn_conv_b, w_ffn_out, final_norm):
    s = x.shape[1]
    t = jnp.arange(s)
    ang_a = rope_angles(t, A_D)
    ang_c = rope_angles(t, C_ROPE)
    ang_row = rope_angles(t // GRID_W, D_D // 2)
    ang_col = rope_angles(t % GRID_W, D_D // 2)
    p1 = A_COLS
    p2 = p1 + B_COLS
    p3 = p2 + C_COLS
    p4 = p3 + D_COLS
    for l in range(DEPTH):
        lam_init = 0.8 - 0.6 * math.exp(-0.3 * l)
        h = rmsnorm(x, attn_norm[l])
        proj = h @ w_in[l]
        a_cols, b_cols, c_cols, d_cols, g_cols = jnp.split(proj, [p1, p2, p3, p4], axis=-1)
        o_a = diff_mixer(a_cols, ang_a, a_lambda_q1[l], a_lambda_k1[l], a_lambda_q2[l], a_lambda_k2[l],
                         a_subln[l], lam_init)
        o_b = natten_mixer(b_cols, b_rpb[l])
        o_c = mla_mixer(c_cols, ang_c, c_q_norm[l], c_kv_norm[l], c_w_uq[l], c_w_ukv[l])
        o_d = gqa_mixer(d_cols, ang_row, ang_col, d_q_norm[l], d_k_norm[l])
        gates = jax.nn.sigmoid(g_cols)
        merged = None
        for i, o in enumerate((o_a, o_b, o_c, o_d)):
            term = gates[..., i * D_MODEL:(i + 1) * D_MODEL] * (o @ w_branch[l, i])
            merged = term if merged is None else merged + term
        x = x + merged @ w_out[l]
        x = x + conv_ffn(rmsnorm(x, ffn_norm[l]), w_ffn_in[l], ffn_conv_w[l], ffn_conv_b[l], w_ffn_out[l])
    return rmsnorm(x, final_norm)


def setup_inputs(seed: int = 0) -> dict:
    key = jax.random.key(seed)
    ks = jax.random.split(key, 24)
    f32 = jnp.float32

    def nrm(k, shape, scale):
        return jax.random.normal(k, shape, f32) * scale

    def gain(k, shape):
        return 1.0 + 0.02 * jax.random.normal(k, shape, f32)

    return {
        "x_prompt": nrm(ks[0], (BATCH, SEQ, D_MODEL), 1.0),
        "x_sample": nrm(ks[1], (DEC_BATCH, DEC_SEQ, D_MODEL), 1.0),
        "attn_norm": gain(ks[2], (DEPTH, D_MODEL)),
        "w_in": nrm(ks[3], (DEPTH, D_MODEL, IN_COLS), D_MODEL ** -0.5),
        "a_lambda_q1": nrm(ks[4], (DEPTH, A_D), 0.1),
        "a_lambda_k1": nrm(ks[5], (DEPTH, A_D), 0.1),
        "a_lambda_q2": nrm(ks[6], (DEPTH, A_D), 0.1),
        "a_lambda_k2": nrm(ks[7], (DEPTH, A_D), 0.1),
        "a_subln": gain(ks[8], (DEPTH, A_VD)),
        "b_rpb": nrm(ks[9], (DEPTH, B_HEADS, 2 * WIN_R - 1, 2 * WIN_C - 1), 0.02),
        "c_q_norm": gain(ks[10], (DEPTH, C_QLORA)),
        "c_kv_norm": gain(ks[11], (DEPTH, C_KVLORA)),
        "c_w_uq": nrm(ks[12], (DEPTH, C_QLORA, C_HEADS * (C_NOPE + C_ROPE)), C_QLORA ** -0.5),
        "c_w_ukv": nrm(ks[13], (DEPTH, C_KVLORA, C_HEADS * (C_NOPE + C_VD)), C_KVLORA ** -0.5),
        "d_q_norm": gain(ks[14], (DEPTH, D_D)),
        "d_k_norm": gain(ks[15], (DEPTH, D_D)),
        "w_branch": nrm(ks[16], (DEPTH, N_BRANCH, BRANCH_W, D_MODEL), BRANCH_W ** -0.5),
        "w_out": nrm(ks[17], (DEPTH, D_MODEL, D_MODEL), D_MODEL ** -0.5),
        "ffn_norm": gain(ks[18], (DEPTH, D_MODEL)),
        "w_ffn_in": nrm(ks[19], (DEPTH, D_MODEL, 2 * FFN_DIM), D_MODEL ** -0.5),
        "ffn_conv_w": nrm(ks[20], (DEPTH, CONV_W, FFN_DIM), CONV_W ** -0.5),
        "ffn_conv_b": nrm(ks[21], (DEPTH, FFN_DIM), 0.01),
        "w_ffn_out": nrm(ks[22], (DEPTH, FFN_DIM, D_MODEL), FFN_DIM ** -0.5),
        "final_norm": gain(ks[23], (D_MODEL,)),
    }


def reference(x_prompt, x_sample, attn_norm, w_in, a_lambda_q1, a_lambda_k1, a_lambda_q2, a_lambda_k2,
              a_subln, b_rpb, c_q_norm, c_kv_norm, c_w_uq, c_w_ukv, d_q_norm, d_k_norm,
              w_branch, w_out, ffn_norm, w_ffn_in, ffn_conv_w, ffn_conv_b, w_ffn_out, final_norm):
    params = (attn_norm, w_in, a_lambda_q1, a_lambda_k1, a_lambda_q2, a_lambda_k2, a_subln,
              b_rpb, c_q_norm, c_kv_norm, c_w_uq, c_w_ukv, d_q_norm, d_k_norm,
              w_branch, w_out, ffn_norm, w_ffn_in, ffn_conv_w, ffn_conv_b, w_ffn_out, final_norm)
    y_prompt = encoder_trunk(x_prompt, *params)
    y_sample = encoder_trunk(x_sample, *params)
    return (y_prompt, y_sample)
```

```cpp
#include <hip/hip_runtime.h>
#include <hip/hip_cooperative_groups.h>
#include <cstdio>
#include <cstdint>
namespace cg = cooperative_groups;

__device__ __forceinline__ int otid() { int t = threadIdx.x; asm volatile("" : "+v"(t)); return t; }
namespace pg8 {
#define PG8_LAS __attribute__((address_space(3)))
typedef unsigned short bf16_t;
typedef short bf16x8 __attribute__((ext_vector_type(8)));
typedef float f32x4 __attribute__((ext_vector_type(4)));
typedef unsigned u32x4 __attribute__((ext_vector_type(4)));
constexpr int BM = 256, BK = 64, HALF = 128, HTB = HALF * BK * 2  , STAGE_BYTES = 8 * HTB, NXCD = 8, WGM = 8;

__host__ __device__ __forceinline__ int lds_byte(int r, int c) { const int st = (r >> 4) * 2 + (c >> 5), rr = r & 15, cc = c & 31, ob = rr * 64 + cc * 2; return st * 1024 + (ob ^ (((ob >> 9) & 1) << 5)); }
__host__ __device__ __forceinline__ void stage_rc(int b, int& R, int& C) { const int st = b / 1024, sb = b % 1024, swz = sb ^ (((sb >> 9) & 1) << 5); R = (st >> 1) * 16 + swz / 64; C = (st & 1) * 32 + (swz % 64) / 2; }
__host__ __device__ __forceinline__ int perm32(int rho) { const int n = rho >> 4, i = rho & 15; return 8 * (i >> 2) + 4 * n + (i & 3); }

struct Unit { int pm, pn; };
struct Gemm { const bf16_t* A; const bf16_t* Bt; int M, N, K; };

struct StaticOrder {
    int nM, nN, nwg, G, c;
    __host__ __device__ void init(int M, int N, int G_, int c_) { nM = M / BM; nN = N / BM; nwg = nM * nN; G = G_; c = c_; }
    __host__ __device__ bool next(int i, Unit& u) const {
        const long L = (long)i * G + c; if (L >= nwg) return false;
        int wgid = (int)L; { const int q = nwg / NXCD, r = nwg % NXCD, xcd = wgid % NXCD, off = wgid / NXCD; wgid = (xcd < r ? xcd * (q + 1) : r * (q + 1) + (xcd - r) * q) + off; }
        const int nig = WGM * nN, gid = wgid / nig, fm = gid * WGM, gsz = (nM - fm) < WGM ? (nM - fm) : WGM;
        u.pm = fm + ((wgid % nig) % gsz); u.pn = (wgid % nig) / gsz; return true;
    }
    __device__ __forceinline__ void a_ready(const Unit&) const {}
    __device__ __forceinline__ void done(const Unit&) const {}
};


__device__ __forceinline__ unsigned cvt_pk_bf16(float lo, float hi) { typedef float f2 __attribute__((ext_vector_type(2))); typedef __bf16 b2 __attribute__((ext_vector_type(2))); f2 v = {lo, hi}; b2 b = __builtin_convertvector(v, b2); return __builtin_bit_cast(unsigned, b); }
__device__ __forceinline__ float sigm(float v) { return __builtin_amdgcn_rcpf(1.0f + __builtin_amdgcn_exp2f(-1.4426950408889634f * v)); }
__device__ __forceinline__ void rows_rstd8(const float* ssq, int row0, int fq, float (&rs)[2][4]) {
    f32x4 p[2][4];
#pragma unroll
    for (int ai = 0; ai < 2; ++ai)
#pragma unroll
        for (int m = 0; m < 4; ++m) p[ai][m] = ((const f32x4*)(ssq + (size_t)(row0 + ai * HALF + m * 16) * 16))[fq];
#pragma unroll
    for (int ai = 0; ai < 2; ++ai)
#pragma unroll
        for (int m = 0; m < 4; ++m) { float v = (p[ai][m][0] + p[ai][m][1]) + (p[ai][m][2] + p[ai][m][3]); v += __shfl_xor(v, 16); v += __shfl_xor(v, 32); rs[ai][m] = __builtin_amdgcn_rsqf(v * (1.0f / 1024.0f) + 1e-6f); }
}
struct EpiProj {
    static constexpr bool PERM = true, AFTER_DRAIN = false, KEEP_ACC = false;
    bf16_t* O; int ldc; int sig_pn0; const float* ssq; bf16_t* rat; int Trows;
    __device__ __forceinline__ void operator()(const f32x4 (&acc)[2][2][4][2], const Unit& u, int wr, int wc, int fr, int fq) const {
        const int row0 = u.pm * BM + wr * 64 + fr; const int col0 = u.pn * BM + wc * 32 + 8 * fq;
        const bool sg = u.pn >= sig_pn0;
        float rs8[2][4]; rows_rstd8(ssq, row0, fq, rs8);
#pragma unroll
        for (int ai = 0; ai < 2; ++ai)
#pragma unroll
            for (int m = 0; m < 4; ++m) { bf16_t* rowp = O + (size_t)(row0 + ai * HALF + m * 16) * ldc + col0;
                const float rs_ = rs8[ai][m];
                f32x4 g0 = acc[ai][0][m][0] * rs_, g1 = acc[ai][0][m][1] * rs_, g2 = acc[ai][1][m][0] * rs_, g3 = acc[ai][1][m][1] * rs_;
                if (sg) {
#pragma unroll
                    for (int j = 0; j < 4; ++j) {
                        const float e0 = fminf(1.0f + __builtin_amdgcn_exp2f(-1.4426950408889634f * g0[j]), 1e6f), e1 = fminf(1.0f + __builtin_amdgcn_exp2f(-1.4426950408889634f * g1[j]), 1e6f);
                        const float e2 = fminf(1.0f + __builtin_amdgcn_exp2f(-1.4426950408889634f * g2[j]), 1e6f), e3 = fminf(1.0f + __builtin_amdgcn_exp2f(-1.4426950408889634f * g3[j]), 1e6f);
                        g0[j] = e1 * __builtin_amdgcn_rcpf(e0); g1[j] = e2 * __builtin_amdgcn_rcpf(e1); g2[j] = e3 * __builtin_amdgcn_rcpf(e2); g3[j] = __builtin_amdgcn_rcpf(e3); }
                }
                if (sg) { typedef unsigned u32x2 __attribute__((ext_vector_type(2)));
                    bf16_t* rp = rat + (size_t)(row0 + ai * HALF + m * 16) * 1024 + (u.pn - sig_pn0) * 64 + 16 * wc + 4 * fq; const size_t pl = (size_t)Trows * 1024;
                    { u32x2 w; w.x = cvt_pk_bf16(g0[0], g0[1]); w.y = cvt_pk_bf16(g0[2], g0[3]); *(u32x2*)rp = w; }
                    { u32x2 w; w.x = cvt_pk_bf16(g1[0], g1[1]); w.y = cvt_pk_bf16(g1[2], g1[3]); *(u32x2*)(rp + pl) = w; }
                    { u32x2 w; w.x = cvt_pk_bf16(g2[0], g2[1]); w.y = cvt_pk_bf16(g2[2], g2[3]); *(u32x2*)(rp + 2 * pl) = w; }
                    { u32x2 w; w.x = cvt_pk_bf16(g3[0], g3[1]); w.y = cvt_pk_bf16(g3[2], g3[3]); *(u32x2*)(rp + 3 * pl) = w; } }
                else {
                { u32x4 w; w.x = cvt_pk_bf16(g0[0], g0[1]); w.y = cvt_pk_bf16(g0[2], g0[3]); w.z = cvt_pk_bf16(g1[0], g1[1]); w.w = cvt_pk_bf16(g1[2], g1[3]); *(u32x4*)rowp = w; }
                { u32x4 w; w.x = cvt_pk_bf16(g2[0], g2[1]); w.y = cvt_pk_bf16(g2[2], g2[3]); w.z = cvt_pk_bf16(g3[0], g3[1]); w.w = cvt_pk_bf16(g3[2], g3[3]); *(u32x4*)(rowp + HALF) = w; } } }
    }
};
struct EpiBranch {
    static constexpr bool PERM = true, AFTER_DRAIN = false, KEEP_ACC = true;
    const bf16_t* rat; int Trows; bf16_t* mb; int nM;
    __device__ __forceinline__ void operator()(f32x4 (&acc)[2][2][4][2], const Unit& u, int wr, int wc, int fr, int fq) const {
        const int i = u.pn >> 2, pn = u.pn & 3, pm = u.pm - i * nM;
        { const int t_ = otid(), l_ = t_ & 63, w_ = t_ >> 6; wr = w_ >> 2; wc = w_ & 3; fr = l_ & 15; fq = l_ >> 4; }
        const int row0 = pm * BM + wr * 64 + fr; const int col0 = pn * BM + wc * 32 + 8 * fq;
        u32x4 gwv[2][4][2];
#pragma unroll
        for (int ai = 0; ai < 2; ++ai)
#pragma unroll
            for (int m = 0; m < 4; ++m) { const bf16_t* grow = rat + ((size_t)i * Trows + (row0 + ai * HALF + m * 16)) * 1024 + col0;
#pragma unroll
                for (int bj = 0; bj < 2; ++bj) gwv[ai][m][bj] = *(const u32x4*)(grow + bj * HALF); }
#pragma unroll
        for (int ai = 0; ai < 2; ++ai)
#pragma unroll
            for (int m = 0; m < 4; ++m) { bf16_t* brow = mb + (size_t)(row0 + ai * HALF + m * 16) * 1024 + col0;
#pragma unroll
                for (int bj = 0; bj < 2; ++bj) { const u32x4 gw = gwv[ai][m][bj]; u32x4 w = {0u, 0u, 0u, 0u};
#pragma unroll
                    for (int n = 0; n < 2; ++n) { const unsigned lo = gw[2 * n], hi_ = gw[2 * n + 1];
                        f32x4 g; g[0] = __uint_as_float(lo << 16); g[1] = __uint_as_float(lo & 0xffff0000u); g[2] = __uint_as_float(hi_ << 16); g[3] = __uint_as_float(hi_ & 0xffff0000u);
                        const f32x4 v = acc[ai][bj][m][n] * g; acc[ai][bj][m][n] = v;
                        if (i == 3) { w[2 * n] = cvt_pk_bf16(v[0], v[1]); w[2 * n + 1] = cvt_pk_bf16(v[2], v[3]); } }
                    if (i == 3) *(u32x4*)(brow + bj * HALF) = w; } }
    }
};
__device__ __forceinline__ float dpp_ror1(float x) { return __builtin_bit_cast(float, __builtin_amdgcn_update_dpp(0, __builtin_bit_cast(int, x), 0x121, 0xf, 0xf, false)); }
__device__ __forceinline__ float dpp_ror15(float x) { return __builtin_bit_cast(float, __builtin_amdgcn_update_dpp(0, __builtin_bit_cast(int, x), 0x12F, 0xf, 0xf, false)); }
struct EpiFfn {
    static constexpr bool PERM = true, AFTER_DRAIN = false, KEEP_ACC = false;
    bf16_t* act; float* edge; const float* ssq; const float* cw; const float* cb; int nblk;
    __device__ __forceinline__ void operator()(const f32x4 (&acc)[2][2][4][2], const Unit& u, int wr, int wc, int fr, int fq) const {
        typedef unsigned u32x2 __attribute__((ext_vector_type(2)));
        { const int t_ = otid(), l_ = t_ & 63, w_ = t_ >> 6; wr = w_ >> 2; wc = w_ & 3; fr = l_ & 15; fq = l_ >> 4; }
        const int row0 = u.pm * BM + wr * 64 + fr; const int ch0 = u.pn * 128 + wc * 32 + 8 * fq;
        constexpr bool r1up = true;
        const size_t esz = (size_t)nblk * 2 * 2816;
        float rs8[2][4]; rows_rstd8(ssq, row0, fq, rs8);
        f32x4 cwv[2][4];
#pragma unroll
        for (int n = 0; n < 2; ++n) { const int ch = ch0 + 4 * n; cwv[n][0] = *(const f32x4*)(cw + ch); cwv[n][1] = *(const f32x4*)(cw + 2816 + ch); cwv[n][2] = *(const f32x4*)(cw + 2 * 2816 + ch); cwv[n][3] = *(const f32x4*)(cb + ch); }
#pragma unroll
        for (int ai = 0; ai < 2; ++ai) {
            const int blk = (u.pm * BM + ai * HALF + wr * 64) >> 6;
            f32x4 ua_prev[2], db_next[2], gcur[2];
#pragma unroll
            for (int n = 0; n < 2; ++n) { gcur[n] = acc[ai][1][0][n] * rs8[ai][0]; ua_prev[n] = (f32x4){0.f, 0.f, 0.f, 0.f};
#pragma unroll
                for (int j = 0; j < 4; ++j) db_next[n][j] = dpp_ror15(gcur[n][j]); }
#pragma unroll
            for (int m = 0; m < 4; ++m) { f32x4 ua[2], db[2], gnext[2]; u32x4 w4; f32x4 cvs[2], uus[2];
                const bool isF = (m == 0) && (fr == 0), isL = (m == 3) && (fr == 15);
#pragma unroll
                for (int n = 0; n < 2; ++n) { db[n] = db_next[n];
#pragma unroll
                    for (int j = 0; j < 4; ++j) ua[n][j] = dpp_ror1(gcur[n][j]);
                    if (m < 3) { gnext[n] = acc[ai][1][m < 3 ? m + 1 : 3][n] * rs8[ai][m < 3 ? m + 1 : 3];
#pragma unroll
                        for (int j = 0; j < 4; ++j) db_next[n][j] = dpp_ror15(gnext[n][j]); }
                    else { gnext[n] = (f32x4){0.f, 0.f, 0.f, 0.f}; db_next[n] = gnext[n]; }
                    const f32x4 w0 = cwv[n][0], w1 = cwv[n][1], w2 = cwv[n][2], bb = cwv[n][3]; const f32x4 uu = acc[ai][0][m][n] * rs8[ai][m]; f32x4 cv;
#pragma unroll
                    for (int j = 0; j < 4; ++j) { const float up = (fr > 0) ? ua[n][j] : ua_prev[n][j]; const float dn = (fr < 15) ? db[n][j] : db_next[n][j];
                        cv[j] = w0[j] * up + w1[j] * gcur[n][j] + w2[j] * dn + bb[j]; }
                    cvs[n] = cv; uus[n] = uu;
                    f32x4 a4;
#pragma unroll
                    for (int j = 0; j < 4; ++j) a4[j] = cv[j] * sigm(cv[j]) * uu[j];
                    w4[2 * n] = cvt_pk_bf16(a4[0], a4[1]); w4[2 * n + 1] = cvt_pk_bf16(a4[2], a4[3]); }
                if (isF || isL) { float* e = edge + ((size_t)blk * 2 + (isL ? 1 : 0)) * 2816 + ch0;
#pragma unroll
                    for (int n = 0; n < 2; ++n) { *(f32x4*)(e + 4 * n) = cvs[n]; *(f32x4*)(e + esz + 4 * n) = uus[n]; *(f32x4*)(e + 2 * esz + 4 * n) = gcur[n]; } }
                else *(u32x4*)(act + (size_t)(row0 + ai * HALF + m * 16) * 2816 + ch0) = w4;
#pragma unroll
                for (int n = 0; n < 2; ++n) { ua_prev[n] = ua[n]; gcur[n] = gnext[n]; }
            }
            asm volatile("" ::: "memory");
        }
    }
};
struct EpiResid {
    static constexpr bool PERM = true, AFTER_DRAIN = false, KEEP_ACC = false;
    bf16_t* xr; float* ssq;
    __device__ __forceinline__ void operator()(const f32x4 (&acc)[2][2][4][2], const Unit& u, int wr, int wc, int fr, int fq) const {
        const int row0 = u.pm * BM + wr * 64 + fr; const int col0 = u.pn * BM + wc * 32 + 8 * fq;
        u32x4 owv[2][4][2];
#pragma unroll
        for (int ai = 0; ai < 2; ++ai)
#pragma unroll
            for (int m = 0; m < 4; ++m) { const bf16_t* xp = xr + (size_t)(row0 + ai * HALF + m * 16) * 1024 + col0;
#pragma unroll
                for (int bj = 0; bj < 2; ++bj) owv[ai][m][bj] = *(const u32x4*)(xp + bj * HALF); }
#pragma unroll
        for (int ai = 0; ai < 2; ++ai)
#pragma unroll
            for (int m = 0; m < 4; ++m) { const int row = row0 + ai * HALF + m * 16; bf16_t* xp = xr + (size_t)row * 1024 + col0; float sq = 0.f;
#pragma unroll
                for (int bj = 0; bj < 2; ++bj) { const u32x4 ow = owv[ai][m][bj]; u32x4 w;
#pragma unroll
                    for (int n = 0; n < 2; ++n) { f32x4 v = acc[ai][bj][m][n]; const unsigned lo = ow[2 * n], hi_ = ow[2 * n + 1];
                        v[0] += __uint_as_float(lo << 16); v[1] += __uint_as_float(lo & 0xffff0000u); v[2] += __uint_as_float(hi_ << 16); v[3] += __uint_as_float(hi_ & 0xffff0000u);
                        sq += (v[0] * v[0] + v[1] * v[1]) + (v[2] * v[2] + v[3] * v[3]);
                        w[2 * n] = cvt_pk_bf16(v[0], v[1]); w[2 * n + 1] = cvt_pk_bf16(v[2], v[3]); }
                    *(u32x4*)(xp + bj * HALF) = w; }
                sq += __shfl_xor(sq, 16); sq += __shfl_xor(sq, 32);
                if (fq == 0) ssq[(size_t)row * 16 + u.pn * 4 + wc] = sq; }
    }
};
struct BranchOrder {
    int nM, G, c;
    __device__ bool next(int i, Unit& u) const { const int tl = (i >> 2) * G + c; if (tl >= nM * 4) return false; const int sub = i & 3; u.pm = sub * nM + (tl >> 2); u.pn = sub * 4 + (tl & 3); return true; }
    __device__ __forceinline__ void a_ready(const Unit&) const {}
    __device__ __forceinline__ void done(const Unit&) const {}
};

template <class Epi, class Sched, bool ALIGN_EPI = false, bool SP2 = false>
__device__ __forceinline__ void gemm_phase(PG8_LAS unsigned char* lds, const Gemm g, const Sched& S, const Epi& E) {
    const int tid = otid(), wid = __builtin_amdgcn_readfirstlane(tid >> 6), lane = tid & 63, wr = wid >> 2, wc = wid & 3, fr = lane & 15, fq = lane >> 4;
    const int K = g.K, nt = K / BK;
    unsigned voffA[2], voffB[2];
#pragma unroll
    for (int i = 0; i < 2; ++i) { int R, C; stage_rc(tid * 16 + i * 8192, R, C); const int Rb = Epi::PERM ? ((R & ~31) + perm32(R & 31)) : R;
        voffA[i] = (unsigned)(R * K + C) * 2u; voffB[i] = (unsigned)(Rb * K + C) * 2u; }
    const size_t kstep = (size_t)(BK * 2);
    const size_t hstep = (size_t)HALF * K * 2;
    const size_t tstep = 2 * hstep;
    const unsigned ldsw = (unsigned)wid * 1024u;
    const int aoff = lds_byte(wr * 64 + fr, fq * 8), boff = lds_byte(wc * 32 + fr, fq * 8);
#define PG8_SA(b, h) (((b) * 2 + (h)) * HTB)
#define PG8_SB(b, h) ((4 + (b) * 2 + (h)) * HTB)
#define PG8_STAGE(bufoff, gbase, voff) do { _Pragma("unroll") for (int _i = 0; _i < 2; ++_i) \
        __builtin_amdgcn_global_load_lds((const unsigned*)((const char*)(gbase) + (voff)[_i]), (PG8_LAS unsigned*)(lds + (bufoff) + ldsw + _i * 8192), 16, 0, 0); } while (0)
#define PG8_LDA(dst, b, h) do { _Pragma("unroll") for (int m = 0; m < 4; ++m) _Pragma("unroll") for (int k = 0; k < 2; ++k) dst[m][k] = *(const PG8_LAS bf16x8*)(lds + PG8_SA(b, h) + aoff + m * 2048 + k * 1024); } while (0)
#define PG8_LDB(dst, b, h) do { _Pragma("unroll") for (int n = 0; n < 2; ++n) _Pragma("unroll") for (int k = 0; k < 2; ++k) dst[n][k] = *(const PG8_LAS bf16x8*)(lds + PG8_SB(b, h) + boff + n * 2048 + k * 1024); } while (0)
#define PG8_MMA(ai, bj, At, Bt) do { __builtin_amdgcn_s_setprio(1); _Pragma("unroll") for (int m = 0; m < 4; ++m) _Pragma("unroll") for (int n = 0; n < 2; ++n) _Pragma("unroll") for (int k = 0; k < 2; ++k) \
        acc[ai][bj][m][n] = __builtin_amdgcn_mfma_f32_16x16x32_bf16(Bt[n][k], At[m][k], acc[ai][bj][m][n], 0, 0, 0); __builtin_amdgcn_s_setprio(0); } while (0)
#define PG8_WAIT_V(n) asm volatile("s_waitcnt vmcnt(" #n ")" ::: "memory")
#define PG8_WAIT_L(n) asm volatile("s_waitcnt lgkmcnt(" #n ")" ::: "memory")
#define PG8_BAR __builtin_amdgcn_s_barrier()
#define PG8_SCHED __builtin_amdgcn_sched_barrier(0)
    Unit cur, nxt; int ui = 0;
    if (!S.next(0, cur)) return;
    f32x4 acc[2][2][4][2];
#pragma unroll
    for (int a = 0; a < 2; ++a)
#pragma unroll
        for (int b = 0; b < 2; ++b)
#pragma unroll
            for (int m = 0; m < 4; ++m)
#pragma unroll
                for (int n = 0; n < 2; ++n) acc[a][b][m][n] = (f32x4){0.f, 0.f, 0.f, 0.f};
    bf16x8 At[4][2], B0[2][2], B1[2][2];
    const char* cA = (const char*)g.A + (size_t)cur.pm * tstep; const char* cB = (const char*)g.Bt + (size_t)cur.pn * tstep;
    S.a_ready(cur);
    if constexpr (SP2) {
        PG8_STAGE(PG8_SB(0, 0), cB, voffB); PG8_STAGE(PG8_SB(0, 1), cB + hstep, voffB); PG8_STAGE(PG8_SA(0, 0), cA, voffA); PG8_STAGE(PG8_SA(0, 1), cA + hstep, voffA);
        if (wr == 1) PG8_BAR;
        PG8_WAIT_V(2); PG8_BAR;
        PG8_STAGE(PG8_SB(1, 0), cB + kstep, voffB); PG8_STAGE(PG8_SA(1, 0), cA + kstep, voffA); PG8_STAGE(PG8_SB(1, 1), cB + hstep + kstep, voffB);
        PG8_WAIT_V(6); PG8_BAR;
    } else {
        PG8_STAGE(PG8_SB(0, 0), cB, voffB); PG8_STAGE(PG8_SA(0, 0), cA, voffA); PG8_STAGE(PG8_SB(0, 1), cB + hstep, voffB); PG8_STAGE(PG8_SA(0, 1), cA + hstep, voffA);
        if (wr == 1) PG8_BAR;
        PG8_WAIT_V(4); PG8_BAR;
        PG8_STAGE(PG8_SB(1, 0), cB + kstep, voffB); PG8_STAGE(PG8_SA(1, 0), cA + kstep, voffA); PG8_STAGE(PG8_SB(1, 1), cB + hstep + kstep, voffB);
        PG8_WAIT_V(6); PG8_BAR;
    }
    for (;;) {
        const bool has_next = S.next(ui + 1, nxt);
        const char* nA = has_next ? (const char*)g.A + (size_t)nxt.pm * tstep : cA; const char* nB = has_next ? (const char*)g.Bt + (size_t)nxt.pn * tstep : cB;
        for (int t = 0; t < nt; t += 2) {
            const bool last = (t == nt - 2);
            const char* a1 = cA + (size_t)(t + 1) * kstep;
            const char* a2 = last ? nA : cA + (size_t)(t + 2) * kstep; const char* b2 = last ? nB : cB + (size_t)(t + 2) * kstep;
            const char* a3 = a2 + kstep; const char* b3 = b2 + kstep;
            if (last && has_next) S.a_ready(nxt);
            if constexpr (SP2) {
            PG8_LDB(B0, 0, 0); PG8_LDB(B1, 0, 1); PG8_SCHED; PG8_LDA(At, 0, 0); PG8_STAGE(PG8_SA(1, 1), a1 + hstep, voffA);
            PG8_WAIT_V(8); PG8_WAIT_L(0); PG8_BAR; PG8_MMA(0, 0, At, B0); PG8_MMA(0, 1, At, B1); PG8_BAR; PG8_SCHED;
            PG8_LDA(At, 0, 1); PG8_STAGE(PG8_SB(0, 0), b2, voffB); PG8_STAGE(PG8_SB(0, 1), b2 + hstep, voffB); PG8_STAGE(PG8_SA(0, 0), a2, voffA);
            PG8_WAIT_V(8); PG8_WAIT_L(0); PG8_BAR; PG8_MMA(1, 0, At, B0); PG8_MMA(1, 1, At, B1); PG8_BAR; PG8_SCHED;
            PG8_LDB(B0, 1, 0); PG8_LDB(B1, 1, 1); PG8_SCHED; PG8_LDA(At, 1, 0); PG8_STAGE(PG8_SA(0, 1), a2 + hstep, voffA);
            PG8_WAIT_V(8); PG8_WAIT_L(0); PG8_BAR; PG8_MMA(0, 0, At, B0); PG8_MMA(0, 1, At, B1); PG8_BAR; PG8_SCHED;
            PG8_LDA(At, 1, 1); PG8_STAGE(PG8_SB(1, 0), b3, voffB); PG8_STAGE(PG8_SB(1, 1), b3 + hstep, voffB); PG8_STAGE(PG8_SA(1, 0), a3, voffA);
            PG8_WAIT_V(8); PG8_WAIT_L(0); PG8_BAR; PG8_MMA(1, 0, At, B0); PG8_MMA(1, 1, At, B1); PG8_BAR; PG8_SCHED;
            } else {
            PG8_LDB(B0, 0, 0); PG8_SCHED; PG8_LDA(At, 0, 0); PG8_STAGE(PG8_SA(1, 1), a1 + hstep, voffA);
            PG8_WAIT_L(8); PG8_BAR; PG8_WAIT_L(0); PG8_MMA(0, 0, At, B0); PG8_BAR; PG8_SCHED;
            PG8_LDB(B1, 0, 1); PG8_STAGE(PG8_SB(0, 0), b2, voffB);
            PG8_BAR; PG8_WAIT_L(0); PG8_MMA(0, 1, At, B1); PG8_BAR;
            PG8_LDA(At, 0, 1); PG8_STAGE(PG8_SA(0, 0), a2, voffA);
            PG8_BAR; PG8_WAIT_L(0); PG8_MMA(1, 0, At, B0); PG8_BAR; PG8_SCHED;
            PG8_STAGE(PG8_SB(0, 1), b2 + hstep, voffB);
            PG8_WAIT_V(6); PG8_BAR; PG8_MMA(1, 1, At, B1); PG8_BAR;
            PG8_LDB(B0, 1, 0); PG8_SCHED; PG8_LDA(At, 1, 0); PG8_STAGE(PG8_SA(0, 1), a2 + hstep, voffA);
            PG8_WAIT_L(8); PG8_BAR; PG8_WAIT_L(0); PG8_MMA(0, 0, At, B0); PG8_BAR; PG8_SCHED;
            PG8_LDB(B1, 1, 1); PG8_STAGE(PG8_SB(1, 0), b3, voffB);
            PG8_BAR; PG8_WAIT_L(0); PG8_MMA(0, 1, At, B1); PG8_BAR;
            PG8_LDA(At, 1, 1); PG8_STAGE(PG8_SA(1, 0), a3, voffA);
            PG8_BAR; PG8_WAIT_L(0); PG8_MMA(1, 0, At, B0); PG8_BAR; PG8_SCHED;
            PG8_STAGE(PG8_SB(1, 1), b3 + hstep, voffB);
            PG8_WAIT_V(6); PG8_BAR; PG8_MMA(1, 1, At, B1); PG8_BAR;
            }
        }
        if constexpr (ALIGN_EPI) { if (wr == 0) PG8_BAR; }
        if constexpr (!Epi::AFTER_DRAIN) { E(acc, cur, wr, wc, fr, fq); S.done(cur); }
        if (!has_next) break;
        if (!Epi::KEEP_ACC || ((ui + 1) & 3) == 0) {
#pragma unroll
        for (int a = 0; a < 2; ++a)
#pragma unroll
            for (int b = 0; b < 2; ++b)
#pragma unroll
                for (int m = 0; m < 4; ++m)
#pragma unroll
                    for (int n = 0; n < 2; ++n) acc[a][b][m][n] = (f32x4){0.f, 0.f, 0.f, 0.f};
        }
        cur = nxt; cA = nA; cB = nB; ++ui;
        if constexpr (ALIGN_EPI) { if (wr == 1) PG8_BAR; }
    }
    PG8_WAIT_V(0);
    if constexpr (!ALIGN_EPI) { if (wr == 0) PG8_BAR; }
    PG8_BAR;
    if constexpr (Epi::AFTER_DRAIN) { E.fused(acc, cur, wr, wc, fr, fq, lds, wid, lane); S.done(cur); }
#undef PG8_SA
#undef PG8_SB
#undef PG8_STAGE
#undef PG8_LDA
#undef PG8_LDB
#undef PG8_MMA
#undef PG8_WAIT_V
#undef PG8_WAIT_L
#undef PG8_BAR
#undef PG8_SCHED
}
}
#define LAS __attribute__((address_space(3)))
typedef unsigned short bf16_t;
typedef short bf16x8 __attribute__((ext_vector_type(8)));
typedef short v4i16_t __attribute__((ext_vector_type(4)));
typedef float f32x4 __attribute__((ext_vector_type(4)));
typedef float f32x16 __attribute__((ext_vector_type(16)));
typedef unsigned u32x4 __attribute__((ext_vector_type(4)));
typedef unsigned u32x2 __attribute__((ext_vector_type(2)));
using pg8::cvt_pk_bf16;

constexpr int DM = 1024, SEQ = 2048, NSEQ = 40, NTOK_P = 32 * SEQ, NTOK = NSEQ * SEQ, DEPTH = 2;
constexpr int TMAX = 32768, NGROUP = 3;
constexpr int NPROJ = 6656;
constexpr int PPITCH = 2560;
constexpr int PA = 0, PB = 768, PD = 1536, PC = 2048, PG = 2560;
constexpr int FF = 2816, NUG = 2 * FF;
constexpr float EPS = 1e-6f, LOG2E = 1.4426950408889634f;
constexpr int NWAVES = 8, NTHR = 512;

constexpr size_t al256(size_t x) { return (x + 255) & ~(size_t)255; }
constexpr size_t WS_WIN = 1 << 20;
constexpr size_t WS_WBR = WS_WIN + al256((size_t)DEPTH * NPROJ * DM * 2);
constexpr size_t WS_WOUT = WS_WBR + al256((size_t)DEPTH * 4 * 1024 * 256 * 2);
constexpr size_t WS_WFI = WS_WOUT + al256((size_t)DEPTH * DM * DM * 2);
constexpr size_t WS_WFO = WS_WFI + al256((size_t)DEPTH * NUG * DM * 2);
constexpr size_t WS_WUQ = WS_WFO + al256((size_t)DEPTH * DM * FF * 2);
constexpr size_t WS_WUKV = WS_WUQ + al256((size_t)DEPTH * 384 * 192 * 2);
constexpr size_t WS_ROPE = WS_WUKV + al256((size_t)DEPTH * 512 * 128 * 2);
constexpr size_t WS_XN = WS_ROPE + al256((size_t)2048 * 16 * 8);
constexpr size_t WS_PROJ = WS_XN + al256((size_t)TMAX * DM * 2);
constexpr size_t WS_RAT = WS_PROJ + al256((size_t)TMAX * PPITCH * 2);
constexpr size_t WS_QC = WS_RAT + al256((size_t)4 * TMAX * 1024 * 2);
constexpr size_t WS_KC = WS_QC + al256((size_t)TMAX * 384 * 2);
constexpr size_t WS_VC = WS_KC + al256((size_t)TMAX * 384 * 2);
constexpr size_t WS_OB = WS_VC + al256((size_t)TMAX * 256 * 2);
constexpr size_t WS_MRG = WS_OB + al256((size_t)4 * TMAX * 256 * 2);
constexpr size_t WS_MB = WS_MRG + al256((size_t)48 << 20);
constexpr size_t WS_UG = WS_MB + al256((size_t)TMAX * DM * 2);
constexpr size_t WS_ACT = WS_UG;
constexpr size_t WS_END = WS_ACT + al256((size_t)TMAX * FF * 2);
static_assert(WS_END <= ((size_t)1 << 30), "workspace map exceeds 1 GiB");
static_assert((size_t)64 * TMAX * 4 + (size_t)3 * (TMAX / 64) * 2 * 2816 * 4 <= ((size_t)48 << 20), "MRG region");

constexpr int LDS_BYTES = 135168;

struct Args { const float* in[24]; float* out; unsigned char* ws; };
#ifndef PH_MASK
#define PH_MASK 0xFFFF
#endif
#ifndef FLK
#define FLK 15
#endif
#ifndef DUP_MASK
#define DUP_MASK 0
#endif
#define PH(k) _Pragma("unroll 1") for (int rep_ = 0; rep_ < (int)(((PH_MASK >> (k)) & 1) + ((DUP_MASK >> (k)) & 1)); ++rep_)

__device__ __forceinline__ float bf2f(bf16_t b) { return __uint_as_float((unsigned)b << 16); }
__device__ __forceinline__ bf16_t f2bf(float f) { return (bf16_t)(cvt_pk_bf16(f, 0.f) & 0xffffu); }
__device__ __forceinline__ float wave_sum(float v) {
#pragma unroll
    for (int o = 1; o < 64; o <<= 1) v += __shfl_xor(v, o);
    return v;
}
__device__ __forceinline__ int crow(int r, int hi) { return (r & 3) + 8 * (r >> 2) + 4 * hi; }
__device__ __forceinline__ v4i16_t vtr(LAS const char* p) { return __builtin_amdgcn_ds_read_tr16_b64_v4i16((LAS v4i16_t*)p); }
#define MFMA32(a, b, c) __builtin_amdgcn_mfma_f32_32x32x16_bf16((a), (b), (c), 0, 0, 0)
#define MFMA16(a, b, c) __builtin_amdgcn_mfma_f32_16x16x32_bf16((a), (b), (c), 0, 0, 0)

__device__ __forceinline__ void transpose_item(const float* W, int K, int N, bf16_t* WT, int n0d, int n0s, float scale, int k0, float* scr, int lane, bool gperm = false, const float* kgain = nullptr) {
    if (gperm) {
        const int cg = n0d - PG + (lane & 31), tg = cg >> 8, cc = cg & 255, gi = 2 * (cc >> 7) + ((cc >> 2) & 1), ch = tg * 64 + 16 * ((cc >> 5) & 3) + 4 * ((cc >> 3) & 3) + (cc & 3);
        const int src = 2400 + gi * 1024 + ch;
#pragma unroll
        for (int i = 0; i < 32; ++i) { const int kk = 2 * i + (lane >> 5); scr[kk * 33 + (lane & 31)] = W[(size_t)(k0 + kk) * N + src] * kgain[k0 + kk]; }
    } else if (n0s >= 0) {
#pragma unroll
        for (int i = 0; i < 32; ++i) { const int kk = 2 * i + (lane >> 5); scr[kk * 33 + (lane & 31)] = W[(size_t)(k0 + kk) * N + n0s + (lane & 31)] * (kgain ? scale * kgain[k0 + kk] : scale); }
    } else {
#pragma unroll
        for (int i = 0; i < 32; ++i) { const int kk = 2 * i + (lane >> 5); scr[kk * 33 + (lane & 31)] = 0.f; }
    }
    __builtin_amdgcn_wave_barrier(); asm volatile("s_waitcnt lgkmcnt(0)" ::: "memory");
    const int c = lane & 7;
#pragma unroll
    for (int j = 0; j < 4; ++j) { const int n = (lane >> 3) + 8 * j; const float* s = scr + (8 * c) * 33 + n;
        u32x4 o; o.x = cvt_pk_bf16(s[0 * 33], s[1 * 33]); o.y = cvt_pk_bf16(s[2 * 33], s[3 * 33]); o.z = cvt_pk_bf16(s[4 * 33], s[5 * 33]); o.w = cvt_pk_bf16(s[6 * 33], s[7 * 33]);
        *(u32x4*)(WT + (size_t)(n0d + n) * K + k0 + 8 * c) = o; }
    __builtin_amdgcn_wave_barrier(); asm volatile("s_waitcnt lgkmcnt(0)" ::: "memory");
}
__device__ __forceinline__ void prologue(const Args& a, unsigned char* ws, char* lds, int gw, int NGW, int wave, int lane) {
    float* scr = (float*)(lds + wave * 16384);
    constexpr int I_IN = 16 * (NPROJ / 32), I_BR = 4 * 4 * 32, I_OUT = 16 * 32, I_FI = 16 * (NUG / 32), I_FO = (FF / 64) * 32, I_UQ = 3 * 12, I_UKV = 2 * 16;
    constexpr int PER_L = I_IN + I_BR + I_OUT + I_FI + I_FO + I_UQ + I_UKV;
    for (int it = gw; it < DEPTH * PER_L; it += NGW) {
        const int l = it / PER_L; int r = it % PER_L;
        if (r < I_IN) { const int nb = r % (NPROJ / 32), kb = r / (NPROJ / 32); const int n0d = nb * 32; int n0s; float sc = 1.f;
            if (n0d < PD) { n0s = n0d; if (n0d < 256) sc = 0.17677669529663687f * LOG2E; else if (n0d >= PB && n0d < PB + 256) sc = 0.125f * LOG2E; }
            else if (n0d < PC) n0s = n0d - PD + 1888;
            else if (n0d < PC + 352) n0s = n0d - PC + 1536;
            else if (n0d < PG) n0s = -1;
            else n0s = n0d - PG + 2400;
            transpose_item(a.in[3] + (size_t)l * DM * 6496, DM, 6496, (bf16_t*)(ws + WS_WIN) + (size_t)l * NPROJ * DM, n0d, n0s, sc, kb * 64, scr, lane, n0d >= PG, a.in[2] + l * DM); continue; }
        r -= I_IN;
        if (r < I_BR) { const int i = r / 128, rr = r % 128, nb = rr % 32, kb = rr / 32;
            transpose_item(a.in[16] + ((size_t)l * 4 + i) * 256 * 1024, 256, 1024, (bf16_t*)(ws + WS_WBR) + ((size_t)l * 4 + i) * 1024 * 256, nb * 32, nb * 32, 1.f, kb * 64, scr, lane); continue; }
        r -= I_BR;
        if (r < I_OUT) { const int nb = r % 32, kb = r / 32;
            transpose_item(a.in[17] + (size_t)l * DM * DM, DM, DM, (bf16_t*)(ws + WS_WOUT) + (size_t)l * DM * DM, nb * 32, nb * 32, 1.f, kb * 64, scr, lane); continue; }
        r -= I_OUT;
        if (r < I_FI) { const int nb = r % (NUG / 32), kb = r / (NUG / 32);
            const int n0d = nb * 32, src0 = ((n0d >> 7) & 1) * FF + (n0d >> 8) * 128 + (n0d & 127);
            transpose_item(a.in[19] + (size_t)l * DM * NUG, DM, NUG, (bf16_t*)(ws + WS_WFI) + (size_t)l * NUG * DM, n0d, src0, 1.f, kb * 64, scr, lane, false, a.in[18] + l * DM); continue; }
        r -= I_FI;
        if (r < I_FO) { const int nb = r % 32, kb = r / 32;
            transpose_item(a.in[22] + (size_t)l * FF * DM, FF, DM, (bf16_t*)(ws + WS_WFO) + (size_t)l * DM * FF, nb * 32, nb * 32, 1.f, kb * 64, scr, lane); continue; }
        r -= I_FO;
        if (r < I_UQ) { const int nb = r % 12, kb = r / 12;
            transpose_item(a.in[12] + (size_t)l * 192 * 384, 192, 384, (bf16_t*)(ws + WS_WUQ) + (size_t)l * 384 * 192, nb * 32, nb * 32, 1.f, kb * 64, scr, lane); continue; }
        r -= I_UQ;
        { const int nb = r % 16, kb = r / 16;
            transpose_item(a.in[13] + (size_t)l * 128 * 512, 128, 512, (bf16_t*)(ws + WS_WUKV) + (size_t)l * 512 * 128, nb * 32, nb * 32, 1.f, kb * 64, scr, lane); }
    }
    float2* rope = (float2*)(ws + WS_ROPE);
    for (int e = gw * 64 + lane; e < 2048 * 16; e += NGW * 64) {
        const int pos = e >> 4, i = e & 15;
        const float inv = exp2f(-(float)i * (13.287712379549449f / 16.0f));
        const float ang = (float)pos * inv;
        const double rev = (double)ang * 0.15915494309189535; const double fr = rev - __builtin_rint(rev);
        rope[e] = make_float2(__builtin_amdgcn_cosf((float)fr), __builtin_amdgcn_sinf((float)fr));
    }
}

__device__ __forceinline__ void convert_phase(const float* xa, const float* xb, int row_g0, int T, bf16_t* XR, float* S0, int gw, int NGW, int lane) {
#pragma unroll 1
    for (int m0 = gw; m0 < T; m0 += 2 * NGW) { const int m1 = (m0 + NGW < T) ? m0 + NGW : m0;
        f32x4 v[2][4];
#pragma unroll
        for (int k = 0; k < 2; ++k) { const int R = row_g0 + (k ? m1 : m0); const float* xr = (R < NTOK_P) ? xa + (size_t)R * DM : xb + (size_t)(R - NTOK_P) * DM;
#pragma unroll
            for (int j = 0; j < 4; ++j) v[k][j] = ((const f32x4*)xr)[lane + 64 * j]; }
#pragma unroll
        for (int k = 0; k < 2; ++k) { const int m = k ? m1 : m0; float s = 0.f;
#pragma unroll
            for (int j = 0; j < 4; ++j) s += (v[k][j].x * v[k][j].x + v[k][j].y * v[k][j].y) + (v[k][j].z * v[k][j].z + v[k][j].w * v[k][j].w);
            s = wave_sum(s);
            u32x2* o8 = (u32x2*)(XR + (size_t)m * DM);
#pragma unroll
            for (int j = 0; j < 4; ++j) { u32x2 w; w.x = cvt_pk_bf16(v[k][j].x, v[k][j].y); w.y = cvt_pk_bf16(v[k][j].z, v[k][j].w); o8[lane + 64 * j] = w; }
            if (lane < 16) S0[(size_t)m * 16 + lane] = (lane == 0) ? s : 0.f; }
    }
}
__device__ __forceinline__ void final_norm_phase(float* out, int row_g0, int T, const bf16_t* XR, const float* S0, const float* gain, int gw, int NGW, int lane) {
    f32x4 g[4];
#pragma unroll
    for (int j = 0; j < 4; ++j) g[j] = ((const f32x4*)gain)[lane + 64 * j];
#pragma unroll 1
    for (int m0 = gw; m0 < T; m0 += 2 * NGW) { const int m1 = (m0 + NGW < T) ? m0 + NGW : m0;
        u32x2 w[2][4]; f32x4 sp[2][4];
#pragma unroll
        for (int k = 0; k < 2; ++k) { const int m = k ? m1 : m0; const u32x2* x8 = (const u32x2*)(XR + (size_t)m * DM);
#pragma unroll
            for (int j = 0; j < 4; ++j) { w[k][j] = x8[lane + 64 * j]; sp[k][j] = ((const f32x4*)(S0 + (size_t)m * 16))[j]; } }
#pragma unroll
        for (int k = 0; k < 2; ++k) { const int m = k ? m1 : m0; float* orow = out + (size_t)(row_g0 + m) * DM;
            const float sq_ = (((sp[k][0][0] + sp[k][0][1]) + (sp[k][0][2] + sp[k][0][3])) + ((sp[k][1][0] + sp[k][1][1]) + (sp[k][1][2] + sp[k][1][3]))) + (((sp[k][2][0] + sp[k][2][1]) + (sp[k][2][2] + sp[k][2][3])) + ((sp[k][3][0] + sp[k][3][1]) + (sp[k][3][2] + sp[k][3][3])));
            const float rstd = 1.0f / sqrtf(sq_ * (1.f / DM) + EPS);
#pragma unroll
            for (int j = 0; j < 4; ++j) { f32x4 v; v.x = __uint_as_float(w[k][j].x << 16) * rstd * g[j].x; v.y = __uint_as_float(w[k][j].x & 0xffff0000u) * rstd * g[j].y; v.z = __uint_as_float(w[k][j].y << 16) * rstd * g[j].z; v.w = __uint_as_float(w[k][j].y & 0xffff0000u) * rstd * g[j].w;
                ((f32x4*)orow)[lane + 64 * j] = v; } }
    }
}
__device__ __forceinline__ void conv_fix_phase(const float* edge, bf16_t* ACT, const float* cw, int T, int gtid, int NT) {
    constexpr int NCH = FF / 8; const int NBLK = T / 64; const size_t esz = (size_t)NBLK * 2 * FF;
#pragma unroll 1
    for (int idx = gtid; idx < NBLK * 2 * NCH; idx += NT) { const int ch = (idx % NCH) * 8, bw = idx / NCH, which = bw & 1, blk = bw >> 1;
        const int row = blk * 64 + (which ? 63 : 0), pos = row & (SEQ - 1);
        const bool nb_ok = which ? (pos < SEQ - 1) : (pos > 0);
        const float* e = edge + (size_t)bw * FF + ch; const float* wv = cw + (which ? 2 * FF : 0) + ch;
        const float* gn = edge + 2 * esz + (size_t)(which ? (blk + 1) * 2 : (blk - 1) * 2 + 1) * FF + ch;
        u32x4 o;
#pragma unroll
        for (int q = 0; q < 2; ++q) { const f32x4 cv = ((const f32x4*)e)[q], uu = ((const f32x4*)(e + esz))[q], wq = ((const f32x4*)wv)[q]; f32x4 gq = {0.f, 0.f, 0.f, 0.f}; if (nb_ok) gq = ((const f32x4*)gn)[q];
            float r[4];
#pragma unroll
            for (int j = 0; j < 4; ++j) { const float c = cv[j] + wq[j] * gq[j]; r[j] = c * pg8::sigm(c) * uu[j]; }
            o[2 * q] = cvt_pk_bf16(r[0], r[1]); o[2 * q + 1] = cvt_pk_bf16(r[2], r[3]); }
        *(u32x4*)(ACT + (size_t)row * FF + ch) = o; }
}

template <int NTK>
__device__ __forceinline__ void pp_elem(const int (&toks)[NTK], bf16_t* PROJ, bf16_t* KC, const float2* rope, const float* dqn, const float* dkn, int lane) {
    int e0, c, sec = 0; bool isD = false; float sc = 1.f; const float* gn = dqn;
    if (lane < 32) { sec = lane >> 1; c = lane & 1; e0 = PA + sec * 32 + c * 8; }
    else if (lane < 56) { const int t = lane - 32, hd = t >> 2; sec = (t >> 1) & 1; c = t & 1; e0 = PD + hd * 64 + sec * 32 + c * 8; isD = true; gn = ((hd < 4) ? dqn : dkn) + sec * 32 + c * 8; sc = (hd < 4) ? 0.125f * LOG2E : 1.f; }
    else { c = lane & 1; e0 = PC + 320 + c * 8; }
    const bool active = lane < 58, isC = lane >= 56;
    u32x4 xa[NTK], xb[NTK]; f32x4 rp[NTK][4];
#pragma unroll
    for (int k = 0; k < NTK; ++k) { const int tok = toks[k], pos = tok & (SEQ - 1); const bf16_t* row = PROJ + (size_t)tok * PPITCH + e0;
        const int pe = isD ? (sec ? (pos & 63) : (pos >> 6)) : pos; const f32x4* rq = (const f32x4*)(rope + pe * 16 + c * 8);
        if (active) { xa[k] = *(const u32x4*)row; xb[k] = *(const u32x4*)(row + 16); } else { xa[k] = (u32x4){0u, 0u, 0u, 0u}; xb[k] = xa[k]; }
#pragma unroll
        for (int q = 0; q < 4; ++q) rp[k][q] = rq[q]; }
    f32x4 g1[2], g2[2];
#pragma unroll
    for (int q = 0; q < 2; ++q) { g1[q] = *(const f32x4*)(gn + 4 * q); g2[q] = *(const f32x4*)(gn + 16 + 4 * q); }
#pragma unroll
    for (int k = 0; k < NTK; ++k) { const int tok = toks[k];
        float x1[8], x2[8]; float ss = 0.f;
#pragma unroll
        for (int q = 0; q < 4; ++q) { x1[2 * q] = __uint_as_float(xa[k][q] << 16); x1[2 * q + 1] = __uint_as_float(xa[k][q] & 0xffff0000u); x2[2 * q] = __uint_as_float(xb[k][q] << 16); x2[2 * q + 1] = __uint_as_float(xb[k][q] & 0xffff0000u); }
#pragma unroll
        for (int j = 0; j < 8; ++j) ss += x1[j] * x1[j] + x2[j] * x2[j];
        ss += __shfl_xor(ss, 1); ss += __shfl_xor(ss, 2);
        if (isD) { const float rstd = __builtin_amdgcn_rsqf(ss * (1.f / 64.f) + EPS);
#pragma unroll
            for (int j = 0; j < 8; ++j) { x1[j] *= rstd * g1[j >> 2][j & 3]; x2[j] *= rstd * g2[j >> 2][j & 3]; } }
        u32x4 oa, ob;
#pragma unroll
        for (int q = 0; q < 4; ++q) { const float c0 = rp[k][q][0], s0 = rp[k][q][1], c1 = rp[k][q][2], s1 = rp[k][q][3];
            oa[q] = cvt_pk_bf16((x1[2 * q] * c0 - x2[2 * q] * s0) * sc, (x1[2 * q + 1] * c1 - x2[2 * q + 1] * s1) * sc);
            ob[q] = cvt_pk_bf16((x2[2 * q] * c0 + x1[2 * q] * s0) * sc, (x2[2 * q + 1] * c1 + x1[2 * q + 1] * s1) * sc); }
        if (active) {
            if (isC) { bf16_t* kc = KC + (size_t)tok * 384 + 64 + c * 8;
#pragma unroll
                for (int hh = 0; hh < 4; ++hh) { *(u32x4*)(kc + hh * 96) = oa; *(u32x4*)(kc + hh * 96 + 16) = ob; } }
            else { bf16_t* row = PROJ + (size_t)tok * PPITCH + e0; *(u32x4*)row = oa; *(u32x4*)(row + 16) = ob; } }
    }
}
__device__ __forceinline__ void pp_mla(int tok0, int hp, const bf16_t* PROJ, bf16_t* QC, bf16_t* KC, bf16_t* VC, const float2* rope, const bf16_t* WuqT, const bf16_t* WukvT, const float* cqn, const float* ckvn, int lane) {
    const int m = lane & 15, quad = lane >> 4, tok = tok0 + m, pos = tok & (SEQ - 1);
    const bf16_t* crow_ = PROJ + (size_t)tok * PPITCH + PC;
    bf16x8 aq[6], ak[4]; float ssq_ = 0.f, ssk_ = 0.f;
#pragma unroll
    for (int ks = 0; ks < 6; ++ks) aq[ks] = *(const bf16x8*)(crow_ + ks * 32 + quad * 8);
#pragma unroll
    for (int ks = 0; ks < 4; ++ks) ak[ks] = *(const bf16x8*)(crow_ + 192 + ks * 32 + quad * 8);
#pragma unroll
    for (int ks = 0; ks < 6; ++ks)
#pragma unroll
        for (int e = 0; e < 8; ++e) { const float x = bf2f((bf16_t)aq[ks][e]); ssq_ += x * x; }
#pragma unroll
    for (int ks = 0; ks < 4; ++ks)
#pragma unroll
        for (int e = 0; e < 8; ++e) { const float x = bf2f((bf16_t)ak[ks][e]); ssk_ += x * x; }
    ssq_ += __shfl_xor(ssq_, 16); ssq_ += __shfl_xor(ssq_, 32); ssk_ += __shfl_xor(ssk_, 16); ssk_ += __shfl_xor(ssk_, 32);
    const float rq = __builtin_amdgcn_rsqf(ssq_ * (1.f / 192.f) + EPS), rk = __builtin_amdgcn_rsqf(ssk_ * (1.f / 128.f) + EPS);
#pragma unroll
    for (int ks = 0; ks < 6; ++ks) { u32x4 w; const f32x4 ga = *(const f32x4*)(cqn + ks * 32 + quad * 8), gb = *(const f32x4*)(cqn + ks * 32 + quad * 8 + 4);
#pragma unroll
        for (int e = 0; e < 4; ++e) { const float g0 = e < 2 ? ga[2 * e] : gb[2 * e - 4], g1 = e < 2 ? ga[2 * e + 1] : gb[2 * e - 3]; w[e] = cvt_pk_bf16(bf2f((bf16_t)aq[ks][2 * e]) * rq * g0, bf2f((bf16_t)aq[ks][2 * e + 1]) * rq * g1); }
        aq[ks] = __builtin_bit_cast(bf16x8, w); }
#pragma unroll
    for (int ks = 0; ks < 4; ++ks) { u32x4 w; const f32x4 ga = *(const f32x4*)(ckvn + ks * 32 + quad * 8), gb = *(const f32x4*)(ckvn + ks * 32 + quad * 8 + 4);
#pragma unroll
        for (int e = 0; e < 4; ++e) { const float g0 = e < 2 ? ga[2 * e] : gb[2 * e - 4], g1 = e < 2 ? ga[2 * e + 1] : gb[2 * e - 3]; w[e] = cvt_pk_bf16(bf2f((bf16_t)ak[ks][2 * e]) * rk * g0, bf2f((bf16_t)ak[ks][2 * e + 1]) * rk * g1); }
        ak[ks] = __builtin_bit_cast(bf16x8, w); }
    const float qs = 0.10206207261596577f * LOG2E;
    f32x4 cs4[2];
#pragma unroll
    for (int q = 0; q < 2; ++q) cs4[q] = *(const f32x4*)(rope + pos * 16 + quad * 4 + 2 * q);
#pragma unroll 1
    for (int hi_ = 0; hi_ < 2; ++hi_) { const int hh = 2 * hp + hi_;
        {   f32x4 acc[6];
#pragma unroll
            for (int nt = 0; nt < 6; ++nt) { acc[nt] = (f32x4){0.f, 0.f, 0.f, 0.f}; const bf16_t* wr_ = WuqT + (size_t)((hh * 6 + nt) * 16 + m) * 192 + quad * 8;
#pragma unroll
                for (int ks = 0; ks < 6; ++ks) acc[nt] = MFMA16(*(const bf16x8*)(wr_ + ks * 32), aq[ks], acc[nt]); }
#pragma unroll
            for (int j = 0; j < 4; ++j) { const float c = cs4[j >> 1][2 * (j & 1)], sn = cs4[j >> 1][2 * (j & 1) + 1]; const float x1 = acc[4][j], x2 = acc[5][j]; acc[4][j] = x1 * c - x2 * sn; acc[5][j] = x2 * c + x1 * sn; }
            bf16_t* qo = QC + (size_t)tok * 384 + hh * 96 + quad * 4;
#pragma unroll
            for (int nt = 0; nt < 6; ++nt) { u32x2 w; w.x = cvt_pk_bf16(acc[nt][0] * qs, acc[nt][1] * qs); w.y = cvt_pk_bf16(acc[nt][2] * qs, acc[nt][3] * qs); *(u32x2*)(qo + nt * 16) = w; } }
        {   f32x4 acc[8];
#pragma unroll
            for (int nt = 0; nt < 8; ++nt) { acc[nt] = (f32x4){0.f, 0.f, 0.f, 0.f}; const bf16_t* wr_ = WukvT + (size_t)((hh * 8 + nt) * 16 + m) * 128 + quad * 8;
#pragma unroll
                for (int ks = 0; ks < 4; ++ks) acc[nt] = MFMA16(*(const bf16x8*)(wr_ + ks * 32), ak[ks], acc[nt]); }
            bf16_t* ko = KC + (size_t)tok * 384 + hh * 96 + quad * 4; bf16_t* vo = VC + (size_t)tok * 256 + hh * 64 + quad * 4;
#pragma unroll
            for (int nt = 0; nt < 4; ++nt) { u32x2 w; w.x = cvt_pk_bf16(acc[nt][0], acc[nt][1]); w.y = cvt_pk_bf16(acc[nt][2], acc[nt][3]); *(u32x2*)(ko + nt * 16) = w;
                u32x2 w2; w2.x = cvt_pk_bf16(acc[nt + 4][0], acc[nt + 4][1]); w2.y = cvt_pk_bf16(acc[nt + 4][2], acc[nt + 4][3]); *(u32x2*)(vo + nt * 16) = w2; } }
    }
}
__device__ __forceinline__ void pp_mla_lds(int tok0, int hh, const bf16_t* PROJ, bf16_t* QC, bf16_t* KC, bf16_t* VC, const float2* rope, const char* Lq, const char* Lkv, const float* cqn, const float* ckvn, int lane) {
    const int m = lane & 15, quad = lane >> 4, tok = tok0 + m, pos = tok & (SEQ - 1);
    const bf16_t* crow_ = PROJ + (size_t)tok * PPITCH + PC;
    bf16x8 aq[6], ak[4]; float ssq_ = 0.f, ssk_ = 0.f;
#pragma unroll
    for (int ks = 0; ks < 6; ++ks) aq[ks] = *(const bf16x8*)(crow_ + ks * 32 + quad * 8);
#pragma unroll
    for (int ks = 0; ks < 4; ++ks) ak[ks] = *(const bf16x8*)(crow_ + 192 + ks * 32 + quad * 8);
#pragma unroll
    for (int ks = 0; ks < 6; ++ks)
#pragma unroll
        for (int e = 0; e < 8; ++e) { const float x = bf2f((bf16_t)aq[ks][e]); ssq_ += x * x; }
#pragma unroll
    for (int ks = 0; ks < 4; ++ks)
#pragma unroll
        for (int e = 0; e < 8; ++e) { const float x = bf2f((bf16_t)ak[ks][e]); ssk_ += x * x; }
    ssq_ += __shfl_xor(ssq_, 16); ssq_ += __shfl_xor(ssq_, 32); ssk_ += __shfl_xor(ssk_, 16); ssk_ += __shfl_xor(ssk_, 32);
    const float rq = __builtin_amdgcn_rsqf(ssq_ * (1.f / 192.f) + EPS), rk = __builtin_amdgcn_rsqf(ssk_ * (1.f / 128.f) + EPS);
#pragma unroll
    for (int ks = 0; ks < 6; ++ks) { u32x4 w; const f32x4 ga = *(const f32x4*)(cqn + ks * 32 + quad * 8), gb = *(const f32x4*)(cqn + ks * 32 + quad * 8 + 4);
#pragma unroll
        for (int e = 0; e < 4; ++e) { const float g0 = e < 2 ? ga[2 * e] : gb[2 * e - 4], g1 = e < 2 ? ga[2 * e + 1] : gb[2 * e - 3]; w[e] = cvt_pk_bf16(bf2f((bf16_t)aq[ks][2 * e]) * rq * g0, bf2f((bf16_t)aq[ks][2 * e + 1]) * rq * g1); }
        aq[ks] = __builtin_bit_cast(bf16x8, w); }
#pragma unroll
    for (int ks = 0; ks < 4; ++ks) { u32x4 w; const f32x4 ga = *(const f32x4*)(ckvn + ks * 32 + quad * 8), gb = *(const f32x4*)(ckvn + ks * 32 + quad * 8 + 4);
#pragma unroll
        for (int e = 0; e < 4; ++e) { const float g0 = e < 2 ? ga[2 * e] : gb[2 * e - 4], g1 = e < 2 ? ga[2 * e + 1] : gb[2 * e - 3]; w[e] = cvt_pk_bf16(bf2f((bf16_t)ak[ks][2 * e]) * rk * g0, bf2f((bf16_t)ak[ks][2 * e + 1]) * rk * g1); }
        ak[ks] = __builtin_bit_cast(bf16x8, w); }
    const float qs = 0.10206207261596577f * LOG2E;
    f32x4 cs4[2];
#pragma unroll
    for (int q = 0; q < 2; ++q) cs4[q] = *(const f32x4*)(rope + pos * 16 + quad * 4 + 2 * q);
    {
        {   f32x4 acc[6];
#pragma unroll
            for (int nt = 0; nt < 6; ++nt) { acc[nt] = (f32x4){0.f, 0.f, 0.f, 0.f}; const char* wr_ = Lq + (nt * 16 + m) * 400 + quad * 16;
#pragma unroll
                for (int ks = 0; ks < 6; ++ks) acc[nt] = MFMA16(*(const bf16x8*)(wr_ + ks * 64), aq[ks], acc[nt]); }
#pragma unroll
            for (int j = 0; j < 4; ++j) { const float c = cs4[j >> 1][2 * (j & 1)], sn = cs4[j >> 1][2 * (j & 1) + 1]; const float x1 = acc[4][j], x2 = acc[5][j]; acc[4][j] = x1 * c - x2 * sn; acc[5][j] = x2 * c + x1 * sn; }
            bf16_t* qo = QC + (size_t)tok * 384 + hh * 96 + quad * 4;
#pragma unroll
            for (int nt = 0; nt < 6; ++nt) { u32x2 w; w.x = cvt_pk_bf16(acc[nt][0] * qs, acc[nt][1] * qs); w.y = cvt_pk_bf16(acc[nt][2] * qs, acc[nt][3] * qs); *(u32x2*)(qo + nt * 16) = w; } }
        {   f32x4 acc[8];
#pragma unroll
            for (int nt = 0; nt < 8; ++nt) { acc[nt] = (f32x4){0.f, 0.f, 0.f, 0.f}; const char* wr_ = Lkv + (nt * 16 + m) * 288 + quad * 16;
#pragma unroll
                for (int ks = 0; ks < 4; ++ks) acc[nt] = MFMA16(*(const bf16x8*)(wr_ + ks * 64), ak[ks], acc[nt]); }
            bf16_t* ko = KC + (size_t)tok * 384 + hh * 96 + quad * 4; bf16_t* vo = VC + (size_t)tok * 256 + hh * 64 + quad * 4;
#pragma unroll
            for (int nt = 0; nt < 4; ++nt) { u32x2 w; w.x = cvt_pk_bf16(acc[nt][0], acc[nt][1]); w.y = cvt_pk_bf16(acc[nt][2], acc[nt][3]); *(u32x2*)(ko + nt * 16) = w;
                u32x2 w2; w2.x = cvt_pk_bf16(acc[nt + 4][0], acc[nt + 4][1]); w2.y = cvt_pk_bf16(acc[nt + 4][2], acc[nt + 4][3]); *(u32x2*)(vo + nt * 16) = w2; } }
    }
}

template <int DQK, int NSUB, int MODE>
__device__ __forceinline__ void flash_unit(LAS char* L, const bf16_t* Qp, int qpitch, const bf16_t* Kp, int kpitch, const bf16_t* Vp, int vpitch,
                                           bf16_t* Op, int opitch, float lam, float oscale, const float* subln) {
    constexpr int KW = NSUB * DQK, KPB = KW * 2 + 16, VPB = 144, KBUF = 64 * KPB, VBUF = 64 * VPB, KCH = KW / 8, NKCH = 64 * KCH, ND0 = DQK / 16;
    constexpr int OFF_V = 2 * KBUF;
    const int tid = otid(), lane = tid & 63, wid = tid >> 6, r32 = lane & 31, hi = lane >> 5;
    char* Lg = (char*)L;
    bf16x8 qf[NSUB][ND0];
    { const bf16_t* qrow = Qp + (size_t)(32 * wid + r32) * qpitch;
#pragma unroll
      for (int s = 0; s < NSUB; ++s)
#pragma unroll
          for (int d0 = 0; d0 < ND0; ++d0) qf[s][d0] = *(const bf16x8*)(qrow + s * DQK + 16 * d0 + 8 * hi); }
    const int kr1 = tid / KCH, kc1 = tid % KCH, kr2 = (tid + 512) / KCH, kc2 = (tid + 512) % KCH; const bool has2 = (tid + 512) < NKCH;
    const int vr1 = tid >> 3, vc1 = tid & 7;
    const bf16_t* kg1 = Kp + (size_t)kr1 * kpitch + kc1 * 8; const bf16_t* kg2 = Kp + (size_t)kr2 * kpitch + kc2 * 8; const bf16_t* vg1 = Vp + (size_t)vr1 * vpitch + vc1 * 8;
    const int kl1 = kr1 * KPB + kc1 * 16, kl2 = kr2 * KPB + kc2 * 16, vl1 = vr1 * VPB + vc1 * 16;
    u32x4 rk1, rk2 = {0u, 0u, 0u, 0u}, rv1;
    float mref[NSUB], lrow[NSUB]; f32x16 o[NSUB][2], negm[NSUB];
#pragma unroll
    for (int s = 0; s < NSUB; ++s) { mref[s] = 0.f; lrow[s] = 0.f;
#pragma unroll
        for (int r = 0; r < 16; ++r) { o[s][0][r] = 0.f; o[s][1][r] = 0.f; negm[s][r] = 0.f; } }
    rk1 = *(const u32x4*)kg1; if (has2) rk2 = *(const u32x4*)kg2; rv1 = *(const u32x4*)vg1;
    __syncthreads();
    *(u32x4*)(Lg + kl1) = rk1; if (has2) *(u32x4*)(Lg + kl2) = rk2; *(u32x4*)(Lg + OFF_V + vl1) = rv1;
    __syncthreads();
    const int vq = (lane & 15) >> 2, vp_ = lane & 3, vblk = (lane >> 4) & 1;
    const int voff = (4 * hi + vq) * VPB + (16 * vblk + 4 * vp_) * 2;
    if (__builtin_amdgcn_readfirstlane(wid) >= 4) __builtin_amdgcn_s_setprio(1);
    for (int t = 0; t < SEQ / 64; ++t) {
        const int buf = t & 1;
        if (t + 1 < SEQ / 64) { const size_t ko = (size_t)(t + 1) * 64 * kpitch, vo = (size_t)(t + 1) * 64 * vpitch;
            rk1 = *(const u32x4*)(kg1 + ko); if (has2) rk2 = *(const u32x4*)(kg2 + ko); rv1 = *(const u32x4*)(vg1 + vo); }
        const char* Kb = Lg + buf * KBUF; LAS const char* Vb = L + OFF_V + buf * VBUF + voff;
#pragma unroll
        for (int s = 0; s < NSUB; ++s) {
            f32x16 p0, p1;
#pragma unroll
            for (int d0 = 0; d0 < ND0; ++d0) { const bf16x8 k0 = *(const bf16x8*)(Kb + r32 * KPB + (s * DQK + 16 * d0 + 8 * hi) * 2); const bf16x8 k1 = *(const bf16x8*)(Kb + (32 + r32) * KPB + (s * DQK + 16 * d0 + 8 * hi) * 2);
                if (d0 == 0) { p0 = MFMA32(k0, qf[s][d0], negm[s]); p1 = MFMA32(k1, qf[s][d0], negm[s]); }
                else { p0 = MFMA32(k0, qf[s][d0], p0); p1 = MFMA32(k1, qf[s][d0], p1); } }
#pragma unroll
            for (int hf = 0; hf < 2; ++hf) {
                f32x16& ph = hf ? p1 : p0;
                float mx = fmaxf(ph[0], ph[1]);
#pragma unroll
                for (int r = 2; r < 16; ++r) mx = fmaxf(mx, ph[r]);
                mx = fmaxf(mx, __shfl_xor(mx, 32));
                const bool first = (t == 0) && (hf == 0);
                if (first || __any(mx > 8.0f)) {
                    const float dl = first ? mx : fmaxf(mx, 0.f); mref[s] += dl;
#pragma unroll
                    for (int r = 0; r < 16; ++r) { ph[r] -= dl; negm[s][r] = -mref[s]; }
                    if (hf == 0) {
#pragma unroll
                        for (int r = 0; r < 16; ++r) p1[r] -= dl;
                    }
                    if (!first) { const float alpha = __builtin_amdgcn_exp2f(-dl); lrow[s] *= alpha;
#pragma unroll
                        for (int r = 0; r < 16; ++r) { o[s][0][r] *= alpha; o[s][1][r] *= alpha; } }
                }
#pragma unroll
                for (int r = 0; r < 16; ++r) ph[r] = __builtin_amdgcn_exp2f(ph[r]);
                { typedef float f32x2_ __attribute__((ext_vector_type(2))); f32x2_ r2 = {ph[0], ph[1]};
#pragma unroll
                  for (int r = 2; r < 16; r += 2) r2 += (f32x2_){ph[r], ph[r + 1]};
                  lrow[s] += r2[0] + r2[1]; }
                bf16x8 pf[2];
#pragma unroll
                for (int k2 = 0; k2 < 2; ++k2) { u32x4 w;
#pragma unroll
                    for (int e = 0; e < 4; ++e) w[e] = cvt_pk_bf16(ph[8 * k2 + 2 * e], ph[8 * k2 + 2 * e + 1]);
                    pf[k2] = __builtin_bit_cast(bf16x8, w); }
#pragma unroll
                for (int db = 0; db < 2; ++db)
#pragma unroll
                    for (int k2 = 0; k2 < 2; ++k2) { const int ks = 2 * hf + k2; const v4i16_t lo = vtr(Vb + (16 * ks) * VPB + db * 64), hh = vtr(Vb + (16 * ks + 8) * VPB + db * 64);
                        const bf16x8 vf = {lo[0], lo[1], lo[2], lo[3], hh[0], hh[1], hh[2], hh[3]};
                        o[s][db] = MFMA32(vf, pf[k2], o[s][db]); }
            }
        }
        if (t + 1 < SEQ / 64) { char* Kn = Lg + (buf ^ 1) * KBUF; *(u32x4*)(Kn + kl1) = rk1; if (has2) *(u32x4*)(Kn + kl2) = rk2; *(u32x4*)(Lg + OFF_V + (buf ^ 1) * VBUF + vl1) = rv1; }
        __syncthreads();
    }
    __builtin_amdgcn_s_setprio(0);
    bf16_t* orow = Op + (size_t)(32 * wid + r32) * opitch;
    if (MODE == 0) {
        const float inv = 1.0f / (lrow[0] + __shfl_xor(lrow[0], 32));
#pragma unroll
        for (int db = 0; db < 2; ++db)
#pragma unroll
            for (int g = 0; g < 4; ++g) { u32x2 w; w.x = cvt_pk_bf16(o[0][db][4 * g] * inv, o[0][db][4 * g + 1] * inv); w.y = cvt_pk_bf16(o[0][db][4 * g + 2] * inv, o[0][db][4 * g + 3] * inv);
                *(u32x2*)(orow + 32 * db + 8 * g + 4 * hi) = w; }
    } else {
        const float i1 = 1.0f / (lrow[0] + __shfl_xor(lrow[0], 32)), i2 = lam / (lrow[NSUB - 1] + __shfl_xor(lrow[NSUB - 1], 32));
        float ss = 0.f;
#pragma unroll
        for (int db = 0; db < 2; ++db)
#pragma unroll
            for (int r = 0; r < 16; ++r) { const float v = o[0][db][r] * i1 - o[NSUB - 1][db][r] * i2; o[0][db][r] = v; ss += v * v; }
        ss += __shfl_xor(ss, 32);
        const float rn = oscale / sqrtf(ss * (1.f / 64.f) + EPS);
#pragma unroll
        for (int db = 0; db < 2; ++db)
#pragma unroll
            for (int g = 0; g < 4; ++g) { const int d = 32 * db + 8 * g + 4 * hi; const f32x4 sg = *(const f32x4*)(subln + d);
                u32x2 w; w.x = cvt_pk_bf16(o[0][db][4 * g] * rn * sg[0], o[0][db][4 * g + 1] * rn * sg[1]); w.y = cvt_pk_bf16(o[0][db][4 * g + 2] * rn * sg[2], o[0][db][4 * g + 3] * rn * sg[3]);
                *(u32x2*)(orow + d) = w; }
    }
}

__device__ __forceinline__ void natten_unit(LAS char* L, const bf16_t* Pseq  , bf16_t* Oseq  , int h, int r0, const float* rpb) {
    constexpr int VPB = 144, OFF_RPB = 11 * 64 * VPB;
    const int tid = otid(), lane = tid & 63, wid = tid >> 6, m = lane & 15, quad = lane >> 4;
    char* Lg = (char*)L; float* rpbL = (float*)(Lg + OFF_RPB);
    int rs_lo = r0 - 4; rs_lo = rs_lo < 0 ? 0 : (rs_lo > 24 ? 24 : rs_lo);
    int rs_hi = r0 + 3 - 4; rs_hi = rs_hi < 0 ? 0 : (rs_hi > 24 ? 24 : rs_hi);
    const int nst = (rs_hi - rs_lo + 8) * 64 * 8;
    __syncthreads();
    {   const bf16_t* vsrc = Pseq + (size_t)(rs_lo * 64) * PPITCH + PB + 512 + h * 64;
#pragma unroll
        for (int i = 0; i < 11; ++i) { const int c = tid + 512 * i; if (c < nst) { const int row = c >> 3, ch = c & 7; *(u32x4*)(Lg + row * VPB + ch * 16) = *(const u32x4*)(vsrc + (size_t)row * PPITCH + ch * 8); } }
        if (tid < 465) rpbL[tid] = rpb[h * 465 + tid] * LOG2E;
    }
    __syncthreads();
#pragma unroll 1
    for (int it = 0; it < 2; ++it) {
        const int item = wid + 8 * it, r = r0 + (item >> 2), n = item & 3;
        int rs = r - 4; rs = rs < 0 ? 0 : (rs > 24 ? 24 : rs);
        int cb = 16 * n - 8; cb = cb < 0 ? 0 : (cb > 32 ? 32 : cb);
        const int qcol = 16 * n + m; int cs = qcol - 8; cs = cs < 0 ? 0 : (cs > 48 ? 48 : cs);
        const bf16_t* qrow = Pseq + (size_t)(r * 64 + qcol) * PPITCH + PB + h * 64 + quad * 8;
        const bf16x8 qf0 = *(const bf16x8*)qrow, qf1 = *(const bf16x8*)(qrow + 32);
        f32x4 sc[16];
#pragma unroll
        for (int t = 0; t < 16; ++t) { const int kr = t >> 1, kc0 = (t & 1) * 16;
            const bf16_t* krow = Pseq + (size_t)((rs + kr) * 64 + cb + kc0 + m) * PPITCH + PB + 256 + h * 64 + quad * 8;
            const bf16x8 k0 = *(const bf16x8*)krow, k1 = *(const bf16x8*)(krow + 32);
            f32x4 a = {0.f, 0.f, 0.f, 0.f}; a = MFMA16(k0, qf0, a); a = MFMA16(k1, qf1, a);
            const int dr = rs + kr - r + 7;
#pragma unroll
            for (int j = 0; j < 4; ++j) { const int kcol = cb + kc0 + 4 * quad + j; const bool ok = (kcol >= cs) && (kcol < cs + 16); int dc = kcol - qcol + 15; dc = dc < 0 ? 0 : (dc > 30 ? 30 : dc);
                a[j] = ok ? a[j] + rpbL[dr * 31 + dc] : -INFINITY; }
            sc[t] = a; }
        float mx = -INFINITY;
#pragma unroll
        for (int t = 0; t < 16; ++t) mx = fmaxf(mx, fmaxf(fmaxf(sc[t][0], sc[t][1]), fmaxf(sc[t][2], sc[t][3])));
        mx = fmaxf(mx, __shfl_xor(mx, 16)); mx = fmaxf(mx, __shfl_xor(mx, 32));
        float sum = 0.f;
#pragma unroll
        for (int t = 0; t < 16; ++t)
#pragma unroll
            for (int j = 0; j < 4; ++j) { const float e = __builtin_amdgcn_exp2f(sc[t][j] - mx); sc[t][j] = e; sum += e; }
        sum += __shfl_xor(sum, 16); sum += __shfl_xor(sum, 32);
        const float inv = 1.0f / sum;
        f32x4 o[4];
#pragma unroll
        for (int dt = 0; dt < 4; ++dt) o[dt] = (f32x4){0.f, 0.f, 0.f, 0.f};
        LAS const char* Vb = L + (size_t)((rs - rs_lo) * 64 + cb + 4 * quad + (m >> 2)) * VPB + (lane & 3) * 8;
#pragma unroll
        for (int u = 0; u < 8; ++u) { u32x4 w; w.x = cvt_pk_bf16(sc[2 * u][0], sc[2 * u][1]); w.y = cvt_pk_bf16(sc[2 * u][2], sc[2 * u][3]);
            w.z = cvt_pk_bf16(sc[2 * u + 1][0], sc[2 * u + 1][1]); w.w = cvt_pk_bf16(sc[2 * u + 1][2], sc[2 * u + 1][3]);
            const bf16x8 pf = __builtin_bit_cast(bf16x8, w);
#pragma unroll
            for (int dt = 0; dt < 4; ++dt) { const v4i16_t lo = vtr(Vb + (u * 64) * VPB + dt * 32), hh = vtr(Vb + (u * 64 + 16) * VPB + dt * 32);
                const bf16x8 vf = {lo[0], lo[1], lo[2], lo[3], hh[0], hh[1], hh[2], hh[3]};
                o[dt] = MFMA16(vf, pf, o[dt]); } }
        bf16_t* orow = Oseq + (size_t)(r * 64 + qcol) * 256 + h * 64 + 4 * quad;
#pragma unroll
        for (int dt = 0; dt < 4; ++dt) { u32x2 w; w.x = cvt_pk_bf16(o[dt][0] * inv, o[dt][1] * inv); w.y = cvt_pk_bf16(o[dt][2] * inv, o[dt][3] * inv); *(u32x2*)(orow + dt * 16) = w; }
    }
}

#define XB_TMO      128
#define XB_XCNT(j)  (256  + 64 * (j))
#define XB_XSUB(j)  (1280 + 64 * (j))
#define XB_XGEN(j)  (2304 + 64 * (j))
#define XB_TOP      3328
#define XB_TOPGEN   3392
#define XCD_BAR_WORDS 3456
#define XB_SPIN_CAP (1u << 18)

__device__ __forceinline__ unsigned xb_ld(unsigned* p)              { return __hip_atomic_load(p, __ATOMIC_RELAXED, __HIP_MEMORY_SCOPE_AGENT); }
__device__ __forceinline__ unsigned xb_add(unsigned* p, unsigned v) { return __hip_atomic_fetch_add(p, v, __ATOMIC_RELAXED, __HIP_MEMORY_SCOPE_AGENT); }
__device__ __forceinline__ unsigned xb_xcc_id() { return (unsigned)__builtin_amdgcn_s_getreg((3 << 11) | 20) & 0xFu; }
#define XB_SPIN(cond, bar) do { unsigned _sp = 0; while (cond) { __builtin_amdgcn_s_sleep(1); \
    if ((++_sp & 255u) == 0u) { if (xb_ld(&(bar)[XB_TMO])) break; if (_sp > XB_SPIN_CAP) { atomicAdd(&(bar)[XB_TMO], 1u); break; } } } } while (0)

struct XcdBarrier {
    unsigned* bar; unsigned x;
    volatile LAS unsigned* st;
};

__device__ __forceinline__ XcdBarrier xcd_barrier_post(unsigned* bar, volatile LAS unsigned* st) {
    XcdBarrier b; b.bar = bar; b.x = xb_xcc_id(); b.st = st;
    if (threadIdx.x == 0) (void)xb_add(&bar[XB_XCNT(b.x)], 1u);
    return b;
}
__device__ __forceinline__ void xcd_barrier_complete(unsigned* bar, unsigned x, unsigned& nloc, unsigned& nx) {
    const unsigned G = gridDim.x * gridDim.y * gridDim.z;
    unsigned sum, cnt, mine, sp = 0u;
    for (;;) {
        sum = 0u; cnt = 0u; mine = 0u;
#pragma unroll
        for (unsigned j = 0; j < 16; ++j) { const unsigned c = xb_ld(&bar[XB_XCNT(j)]); sum += c; cnt += (c > 0u) ? 1u : 0u; mine = (j == x) ? c : mine; }
        if (sum == G) break;
        __builtin_amdgcn_s_sleep(1);
        if ((++sp & 255u) == 0u) { if (xb_ld(&bar[XB_TMO])) break; if (sp > XB_SPIN_CAP) { atomicAdd(&bar[XB_TMO], 1u); break; } }
    }
    nloc = mine > 0u ? mine : 1u; nx = cnt > 0u ? cnt : 1u;
}

__device__ __forceinline__ void xcd_barrier(const XcdBarrier& b) {
    asm volatile("s_waitcnt vmcnt(0)" ::: "memory");
    __syncthreads();
    if (threadIdx.x == 0) {
        unsigned* bar = b.bar;
        __builtin_amdgcn_s_waitcnt(0);
        unsigned nloc = b.st[0], nx = b.st[1];
        if (nloc == 0u) { xcd_barrier_complete(bar, b.x, nloc, nx); b.st[0] = nloc; b.st[1] = nx; }
        const unsigned old = xb_add(&bar[XB_XSUB(b.x)], 1u);
        const unsigned gen = old / nloc;
        if (old + 1u == (gen + 1u) * nloc) {
            __builtin_amdgcn_fence(__ATOMIC_RELEASE, "agent");
            asm volatile("s_waitcnt vmcnt(0)" ::: "memory");
            const unsigned og = xb_add(&bar[XB_TOP], 1u);
            const unsigned tg = og / nx;
            if (og + 1u == (tg + 1u) * nx) xb_add(&bar[XB_TOPGEN], 1u);
            else XB_SPIN(xb_ld(&bar[XB_TOPGEN]) == tg, bar);
            __builtin_amdgcn_fence(__ATOMIC_ACQUIRE, "agent");
            xb_add(&bar[XB_XGEN(b.x)], 1u);
            asm volatile("s_waitcnt vmcnt(0)" ::: "memory");
        } else {
            XB_SPIN(xb_ld(&bar[XB_XGEN(b.x)]) == gen, bar);
            __builtin_amdgcn_fence(__ATOMIC_ACQUIRE, "agent");
            asm volatile("s_waitcnt vmcnt(0)" ::: "memory");
        }
    }
    __syncthreads();
}

__global__ void __launch_bounds__(NTHR, 2) mega_fwd(Args a) {
    extern __shared__ __attribute__((aligned(16))) unsigned char lds_raw[];
    cg::grid_group grid = cg::this_grid();
    LAS unsigned char* lds = (LAS unsigned char*)lds_raw;
    const int G = gridDim.x, bx = blockIdx.x;
    const int vcu = (G % 8 == 0) ? (bx % 8) * (G / 8) + bx / 8 : bx;
    const int NGW = G * NWAVES, NT = G * NTHR;
#define TIDS() const int tid = otid(), lane = tid & 63, wave = __builtin_amdgcn_readfirstlane(tid >> 6), gw = vcu * NWAVES + wave, gtid = vcu * NTHR + tid; (void)lane; (void)gw; (void)gtid
#define WSP(name) unsigned char* name = a.ws; asm volatile("" : "+s"(name))

    volatile LAS unsigned* MISC = (volatile LAS unsigned*)(lds + 133120);
    if (otid() < 32) MISC[otid()] = 0u;
    __syncthreads();
    XcdBarrier bar = xcd_barrier_post((unsigned*)a.ws, MISC + 8);
#define GSYNC() xcd_barrier(bar)
    PH(0) { WSP(w); TIDS(); prologue(a, w, (char*)lds_raw, gw, NGW, wave, lane); }
    grid.sync();

#pragma unroll 1
    for (int g = 0; g < NGROUP; ++g) {
#pragma unroll 1
        for (int l = 0; l < DEPTH; ++l) {
            int row_g0 = g * TMAX, T = (g < 2) ? TMAX : (NTOK - 2 * TMAX); asm volatile("" : "+s"(row_g0), "+s"(T));
            if (l == 0) {
                PH(1) { WSP(w); TIDS(); convert_phase(a.in[0], a.in[1], row_g0, T, (bf16_t*)(w + WS_XN), (float*)(w + WS_MRG), gw, NGW, lane); }
                GSYNC();
            }
            PH(2) { WSP(w); pg8::Gemm gm{(const bf16_t*)(w + WS_XN), (const bf16_t*)(w + WS_WIN) + (size_t)l * NPROJ * DM, T, NPROJ, DM}; pg8::StaticOrder S; S.init(T, NPROJ, G, bx); pg8::EpiProj E{(bf16_t*)(w + WS_PROJ), PPITCH, PG / 256, (const float*)(w + WS_MRG), (bf16_t*)(w + WS_RAT), T};
              pg8::gemm_phase<pg8::EpiProj, pg8::StaticOrder, true, true>(lds, gm, S, E); }
            GSYNC();
            PH(3) { WSP(w); TIDS(); bf16_t* PROJ = (bf16_t*)(w + WS_PROJ);
                bf16_t* KC = (bf16_t*)(w + WS_KC); const float2* rope = (const float2*)(w + WS_ROPE);
#pragma unroll 1
                for (int t0 = gw; t0 < T; t0 += 2 * NGW) { if (t0 + NGW < T) { const int tk[2] = {t0, t0 + NGW}; pp_elem<2>(tk, PROJ, KC, rope, a.in[14] + l * 64, a.in[15] + l * 64, lane); }
                                                          else { const int tk[1] = {t0}; pp_elem<1>(tk, PROJ, KC, rope, a.in[14] + l * 64, a.in[15] + l * 64, lane); } }
                }
#pragma unroll 1
                for (int hh = 0; hh < 4; ++hh) { WSP(w2); TIDS(); char* Lw = (char*)lds_raw;
                    const bf16_t* Wq_ = (const bf16_t*)(w2 + WS_WUQ) + (size_t)l * 384 * 192 + (size_t)hh * 96 * 192; const bf16_t* Wkv_ = (const bf16_t*)(w2 + WS_WUKV) + (size_t)l * 512 * 128 + (size_t)hh * 128 * 128;
                    __syncthreads();
#pragma unroll
                    for (int i_ = 0; i_ < 9; ++i_) { const int c = tid + 512 * i_;
                        if (c < 2304) { const int row = c / 24, ch = c - row * 24; *(u32x4*)(Lw + row * 400 + ch * 16) = *(const u32x4*)(Wq_ + row * 192 + ch * 8); }
                        else if (c < 4352) { const int c2 = c - 2304, row = c2 >> 4, ch = c2 & 15; *(u32x4*)(Lw + 38400 + row * 288 + ch * 16) = *(const u32x4*)(Wkv_ + row * 128 + ch * 8); } }
                    __syncthreads();
#pragma unroll 1
                    for (int tl = gw; tl < T / 16; tl += NGW) pp_mla_lds(tl * 16, hh, (const bf16_t*)(w2 + WS_PROJ), (bf16_t*)(w2 + WS_QC), (bf16_t*)(w2 + WS_KC), (bf16_t*)(w2 + WS_VC), (const float2*)(w2 + WS_ROPE), Lw, Lw + 38400, a.in[10] + l * 192, a.in[11] + l * 128, lane);
                }
            GSYNC();
            PH(4) {
                const float lam_init = (l == 0) ? 0.2f : (0.8f - 0.6f * 0.7408182206817179f);
                const int NU_F = (T >> 11) * 4 * 8, NU_B = (T >> 11) * 4 * 8;
                if (FLK & 1) {
                    float s1 = 0.f, s2 = 0.f;
                    for (int i = 0; i < 32; ++i) { s1 += a.in[4][l * 32 + i] * a.in[5][l * 32 + i]; s2 += a.in[6][l * 32 + i] * a.in[7][l * 32 + i]; }
                    const float lam = expf(s1) - expf(s2) + lam_init;
#pragma unroll 1
                    for (int uu = vcu; uu < NU_F; uu += G) { WSP(w); bf16_t* PROJ = (bf16_t*)(w + WS_PROJ); bf16_t* OB = (bf16_t*)(w + WS_OB);
                        const int b = uu >> 5, h = (uu >> 3) & 3, qb = uu & 7; const size_t sb = (size_t)b * SEQ, q0 = sb + (size_t)qb * 256;
                        flash_unit<32, 2, 1>((LAS char*)lds, PROJ + q0 * PPITCH + PA + h * 64, PPITCH, PROJ + sb * PPITCH + PA + 256 + h * 64, PPITCH, PROJ + sb * PPITCH + PA + 512 + h * 64, PPITCH,
                                             OB + q0 * 256 + h * 64, 256, lam, 1.0f - lam_init, a.in[8] + l * 64); } }
                if (FLK & 2) {
#pragma unroll 1
                    for (int uu = vcu; uu < NU_F; uu += G) { WSP(w); bf16_t* QC = (bf16_t*)(w + WS_QC); bf16_t* KC = (bf16_t*)(w + WS_KC); bf16_t* VC = (bf16_t*)(w + WS_VC); bf16_t* OB = (bf16_t*)(w + WS_OB);
                        const int b = uu >> 5, h = (uu >> 3) & 3, qb = uu & 7; const size_t sb = (size_t)b * SEQ, q0 = sb + (size_t)qb * 256;
                        flash_unit<96, 1, 0>((LAS char*)lds, QC + q0 * 384 + h * 96, 384, KC + sb * 384 + h * 96, 384, VC + sb * 256 + h * 64, 256,
                                             OB + (size_t)2 * T * 256 + q0 * 256 + h * 64, 256, 0.f, 1.f, nullptr); } }
                if (FLK & 4) {
#pragma unroll 1
                    for (int uu = vcu; uu < NU_F; uu += G) { WSP(w); bf16_t* PROJ = (bf16_t*)(w + WS_PROJ); bf16_t* OB = (bf16_t*)(w + WS_OB);
                        const int b = uu >> 5, h = (uu >> 3) & 3, qb = uu & 7; const size_t sb = (size_t)b * SEQ, q0 = sb + (size_t)qb * 256;
                        flash_unit<64, 1, 0>((LAS char*)lds, PROJ + q0 * PPITCH + PD + h * 64, PPITCH, PROJ + sb * PPITCH + PD + 256 + (h >> 1) * 64, PPITCH, PROJ + sb * PPITCH + PD + 384 + (h >> 1) * 64, PPITCH,
                                             OB + (size_t)3 * T * 256 + q0 * 256 + h * 64, 256, 0.f, 1.f, nullptr); } }
                if (FLK & 8) {
#pragma unroll 1
                    for (int uu = vcu; uu < NU_B; uu += G) { WSP(w); bf16_t* PROJ = (bf16_t*)(w + WS_PROJ); bf16_t* OB = (bf16_t*)(w + WS_OB);
                        const int b = uu >> 5, h = (uu >> 3) & 3, r0 = (uu & 7) * 4;
                        natten_unit((LAS char*)lds, PROJ + (size_t)b * SEQ * PPITCH, OB + (size_t)1 * T * 256 + (size_t)b * SEQ * 256, h, r0, a.in[9] + l * 4 * 465); } }
            }
            GSYNC();
            PH(5) { WSP(w); pg8::Gemm gm{(const bf16_t*)(w + WS_OB), (const bf16_t*)(w + WS_WBR) + (size_t)l * 4 * 1024 * 256, 4 * T, 4096, 256}; pg8::BranchOrder S{T / 256, G, bx};
              pg8::EpiBranch E{(const bf16_t*)(w + WS_RAT), T, (bf16_t*)(w + WS_MB), T / 256};
              pg8::gemm_phase<pg8::EpiBranch, pg8::BranchOrder, true, true>(lds, gm, S, E); }
            GSYNC();
            PH(6) { WSP(w); pg8::Gemm gm{(const bf16_t*)(w + WS_MB), (const bf16_t*)(w + WS_WOUT) + (size_t)l * DM * DM, T, DM, DM}; asm volatile("" : "+s"(gm.A), "+s"(gm.Bt)); pg8::StaticOrder S; S.init(T, DM, G, bx);
              pg8::EpiResid E{(bf16_t*)(w + WS_XN), (float*)(w + WS_MRG) + 16 * TMAX};
              pg8::gemm_phase<pg8::EpiResid, pg8::StaticOrder, true, true>(lds, gm, S, E); }
            GSYNC();
            PH(8) { WSP(w); pg8::Gemm gm{(const bf16_t*)(w + WS_XN), (const bf16_t*)(w + WS_WFI) + (size_t)l * NUG * DM, T, NUG, DM}; asm volatile("" : "+s"(gm.A), "+s"(gm.Bt)); pg8::StaticOrder S; S.init(T, NUG, G, bx);
              pg8::EpiFfn E{(bf16_t*)(w + WS_ACT), (float*)(w + WS_MRG) + 64 * TMAX, (const float*)(w + WS_MRG) + 16 * TMAX, a.in[20] + (size_t)l * 3 * FF, a.in[21] + (size_t)l * FF, T / 64};
              pg8::gemm_phase<pg8::EpiFfn, pg8::StaticOrder, true, true>(lds, gm, S, E); }
            GSYNC();
            PH(9) { WSP(w); TIDS(); conv_fix_phase((const float*)(w + WS_MRG) + 64 * TMAX, (bf16_t*)(w + WS_ACT), a.in[20] + (size_t)l * 3 * FF, T, gtid, NT); }
            GSYNC();
            PH(10) { WSP(w); pg8::Gemm gm{(const bf16_t*)(w + WS_ACT), (const bf16_t*)(w + WS_WFO) + (size_t)l * DM * FF, T, DM, FF}; asm volatile("" : "+s"(gm.A), "+s"(gm.Bt)); pg8::StaticOrder S; S.init(T, DM, G, bx);
              pg8::EpiResid E{(bf16_t*)(w + WS_XN), (float*)(w + WS_MRG)};
              pg8::gemm_phase<pg8::EpiResid, pg8::StaticOrder, true, true>(lds, gm, S, E); }
            GSYNC();
            PH(11) { WSP(w); TIDS(); if (l == DEPTH - 1) final_norm_phase(a.out, row_g0, T, (const bf16_t*)(w + WS_XN), (const float*)(w + WS_MRG), a.in[23], gw, NGW, lane); }
            if (l == DEPTH - 1) GSYNC();
        }
    }
}

extern "C" void kernel_launch(void* const* d_in, const int* in_sizes, int n_in, void* d_out, int out_size, void* d_ws, size_t ws_size, hipStream_t stream) {
    static int grid = 0;
    if (grid == 0) {
        if (n_in != 24 || out_size != NTOK * DM || ws_size < WS_END) { fprintf(stderr, "kernel_launch: unexpected shapes (n_in %d, out %d, ws %zu)\n", n_in, out_size, ws_size); grid = -1; return; }
        int dev = 0, cus = 0, per_cu = 0;
        if (hipGetDevice(&dev) != hipSuccess || hipDeviceGetAttribute(&cus, hipDeviceAttributeMultiprocessorCount, dev) != hipSuccess) { grid = -1; return; }
        if (hipFuncSetAttribute((const void*)mega_fwd, hipFuncAttributeMaxDynamicSharedMemorySize, LDS_BYTES) != hipSuccess) { fprintf(stderr, "kernel_launch: hipFuncSetAttribute failed\n"); grid = -1; return; }
        if (hipOccupancyMaxActiveBlocksPerMultiprocessor(&per_cu, (const void*)mega_fwd, NTHR, LDS_BYTES) != hipSuccess || per_cu < 1) { fprintf(stderr, "kernel_launch: occupancy query says %d\n", per_cu); per_cu = 1; }
        (void)hipGetLastError();
        grid = cus * per_cu;
    }
    if (grid < 0) return;
    if (hipMemsetAsync(d_ws, 0, 16384, stream) != hipSuccess) { fprintf(stderr, "kernel_launch: memset of barrier words failed\n"); return; }
    Args a{};
    for (int i = 0; i < 24; ++i) a.in[i] = (const float*)d_in[i];
    a.out = (float*)d_out; a.ws = (unsigned char*)d_ws;
    void* args[] = {&a};
    hipError_t e = hipLaunchCooperativeKernel((const void*)mega_fwd, dim3(grid), dim3(NTHR), args, LDS_BYTES, stream);
    if (e != hipSuccess) fprintf(stderr, "kernel_launch: cooperative launch failed: %s (grid %d)\n", hipGetErrorString(e), grid);
}
```

```cpp
#include <hip/hip_runtime.h>
#include <hip/hip_cooperative_groups.h>
#include <cstdio>
#include <cstdint>
namespace cg = cooperative_groups;

__device__ __forceinline__ int otid() { int t = threadIdx.x; asm volatile("" : "+v"(t)); return t; }
namespace pg8 {
#define PG8_LAS __attribute__((address_space(3)))
typedef unsigned short bf16_t;
typedef short bf16x8 __attribute__((ext_vector_type(8)));
typedef float f32x4 __attribute__((ext_vector_type(4)));
typedef unsigned u32x4 __attribute__((ext_vector_type(4)));
constexpr int BM = 256, BK = 64, HALF = 128, HTB = HALF * BK * 2  , STAGE_BYTES = 8 * HTB, NXCD = 8, WGM = 8;

__host__ __device__ __forceinline__ int lds_byte(int r, int c) { const int st = (r >> 4) * 2 + (c >> 5), rr = r & 15, cc = c & 31, ob = rr * 64 + cc * 2; return st * 1024 + (ob ^ (((ob >> 9) & 1) << 5)); }
__host__ __device__ __forceinline__ void stage_rc(int b, int& R, int& C) { const int st = b / 1024, sb = b % 1024, swz = sb ^ (((sb >> 9) & 1) << 5); R = (st >> 1) * 16 + swz / 64; C = (st & 1) * 32 + (swz % 64) / 2; }
__host__ __device__ __forceinline__ int perm32(int rho) { const int n = rho >> 4, i = rho & 15; return 8 * (i >> 2) + 4 * n + (i & 3); }

struct Unit { int pm, pn; };
struct Gemm { const bf16_t* A; const bf16_t* Bt; int M, N, K; };

struct StaticOrder {
    int nM, nN, nwg, G, c;
    __host__ __device__ void init(int M, int N, int G_, int c_) { nM = M / BM; nN = N / BM; nwg = nM * nN; G = G_; c = c_; }
    __host__ __device__ bool next(int i, Unit& u) const {
        const long L = (long)i * G + c; if (L >= nwg) return false;
        int wgid = (int)L; { const int q = nwg / NXCD, r = nwg % NXCD, xcd = wgid % NXCD, off = wgid / NXCD; wgid = (xcd < r ? xcd * (q + 1) : r * (q + 1) + (xcd - r) * q) + off; }
        const int nig = WGM * nN, gid = wgid / nig, fm = gid * WGM, gsz = (nM - fm) < WGM ? (nM - fm) : WGM;
        u.pm = fm + ((wgid % nig) % gsz); u.pn = (wgid % nig) / gsz; return true;
    }
    __device__ __forceinline__ void a_ready(const Unit&) const {}
    __device__ __forceinline__ void done(const Unit&) const {}
};


__device__ __forceinline__ unsigned cvt_pk_bf16(float lo, float hi) { typedef float f2 __attribute__((ext_vector_type(2))); typedef __bf16 b2 __attribute__((ext_vector_type(2))); f2 v = {lo, hi}; b2 b = __builtin_convertvector(v, b2); return __builtin_bit_cast(unsigned, b); }
__device__ __forceinline__ float sigm(float v) { return __builtin_amdgcn_rcpf(1.0f + __builtin_amdgcn_exp2f(-1.4426950408889634f * v)); }
__device__ __forceinline__ void rows_rstd8(const float* ssq, int row0, int fq, float (&rs)[2][4]) {
    f32x4 p[2][4];
#pragma unroll
    for (int ai = 0; ai < 2; ++ai)
#pragma unroll
        for (int m = 0; m < 4; ++m) p[ai][m] = ((const f32x4*)(ssq + (size_t)(row0 + ai * HALF + m * 16) * 16))[fq];
#pragma unroll
    for (int ai = 0; ai < 2; ++ai)
#pragma unroll
        for (int m = 0; m < 4; ++m) { float v = (p[ai][m][0] + p[ai][m][1]) + (p[ai][m][2] + p[ai][m][3]); v += __shfl_xor(v, 16); v += __shfl_xor(v, 32); rs[ai][m] = __builtin_amdgcn_rsqf(v * (1.0f / 1024.0f) + 1e-6f); }
}
struct EpiProj {
    static constexpr bool PERM = true, AFTER_DRAIN = false, KEEP_ACC = false;
    bf16_t* O; int ldc; int sig_pn0; const float* ssq; bf16_t* rat; int Trows;
    __device__ __forceinline__ void operator()(const f32x4 (&acc)[2][2][4][2], const Unit& u, int wr, int wc, int fr, int fq) const {
        const int row0 = u.pm * BM + wr * 64 + fr; const int col0 = u.pn * BM + wc * 32 + 8 * fq;
        const bool sg = u.pn >= sig_pn0;
        float rs8[2][4]; rows_rstd8(ssq, row0, fq, rs8);
#pragma unroll
        for (int ai = 0; ai < 2; ++ai)
#pragma unroll
            for (int m = 0; m < 4; ++m) { bf16_t* rowp = O + (size_t)(row0 + ai * HALF + m * 16) * ldc + col0;
                const float rs_ = rs8[ai][m];
                f32x4 g0 = acc[ai][0][m][0] * rs_, g1 = acc[ai][0][m][1] * rs_, g2 = acc[ai][1][m][0] * rs_, g3 = acc[ai][1][m][1] * rs_;
                if (sg) {
#pragma unroll
                    for (int j = 0; j < 4; ++j) {
                        const float e0 = fminf(1.0f + __builtin_amdgcn_exp2f(-1.4426950408889634f * g0[j]), 1e6f), e1 = fminf(1.0f + __builtin_amdgcn_exp2f(-1.4426950408889634f * g1[j]), 1e6f);
                        const float e2 = fminf(1.0f + __builtin_amdgcn_exp2f(-1.4426950408889634f * g2[j]), 1e6f), e3 = fminf(1.0f + __builtin_amdgcn_exp2f(-1.4426950408889634f * g3[j]), 1e6f);
                        g0[j] = e1 * __builtin_amdgcn_rcpf(e0); g1[j] = e2 * __builtin_amdgcn_rcpf(e1); g2[j] = e3 * __builtin_amdgcn_rcpf(e2); g3[j] = __builtin_amdgcn_rcpf(e3); }
                }
                if (sg) { typedef unsigned u32x2 __attribute__((ext_vector_type(2)));
                    bf16_t* rp = rat + (size_t)(row0 + ai * HALF + m * 16) * 1024 + (u.pn - sig_pn0) * 64 + 16 * wc + 4 * fq; const size_t pl = (size_t)Trows * 1024;
                    { u32x2 w; w.x = cvt_pk_bf16(g0[0], g0[1]); w.y = cvt_pk_bf16(g0[2], g0[3]); *(u32x2*)rp = w; }
                    { u32x2 w; w.x = cvt_pk_bf16(g1[0], g1[1]); w.y = cvt_pk_bf16(g1[2], g1[3]); *(u32x2*)(rp + pl) = w; }
                    { u32x2 w; w.x = cvt_pk_bf16(g2[0], g2[1]); w.y = cvt_pk_bf16(g2[2], g2[3]); *(u32x2*)(rp + 2 * pl) = w; }
                    { u32x2 w; w.x = cvt_pk_bf16(g3[0], g3[1]); w.y = cvt_pk_bf16(g3[2], g3[3]); *(u32x2*)(rp + 3 * pl) = w; } }
                else {
                { u32x4 w; w.x = cvt_pk_bf16(g0[0], g0[1]); w.y = cvt_pk_bf16(g0[2], g0[3]); w.z = cvt_pk_bf16(g1[0], g1[1]); w.w = cvt_pk_bf16(g1[2], g1[3]); *(u32x4*)rowp = w; }
                { u32x4 w; w.x = cvt_pk_bf16(g2[0], g2[1]); w.y = cvt_pk_bf16(g2[2], g2[3]); w.z = cvt_pk_bf16(g3[0], g3[1]); w.w = cvt_pk_bf16(g3[2], g3[3]); *(u32x4*)(rowp + HALF) = w; } } }
    }
};
struct EpiBranch {
    static constexpr bool PERM = true, AFTER_DRAIN = false, KEEP_ACC = true;
    const bf16_t* rat; int Trows; bf16_t* mb; int nM;
    __device__ __forceinline__ void operator()(f32x4 (&acc)[2][2][4][2], const Unit& u, int wr, int wc, int fr, int fq) const {
        const int i = u.pn >> 2, pn = u.pn & 3, pm = u.pm - i * nM;
        { const int t_ = otid(), l_ = t_ & 63, w_ = t_ >> 6; wr = w_ >> 2; wc = w_ & 3; fr = l_ & 15; fq = l_ >> 4; }
        const int row0 = pm * BM + wr * 64 + fr; const int col0 = pn * BM + wc * 32 + 8 * fq;
        u32x4 gwv[2][4][2];
#pragma unroll
        for (int ai = 0; ai < 2; ++ai)
#pragma unroll
            for (int m = 0; m < 4; ++m) { const bf16_t* grow = rat + ((size_t)i * Trows + (row0 + ai * HALF + m * 16)) * 1024 + col0;
#pragma unroll
                for (int bj = 0; bj < 2; ++bj) gwv[ai][m][bj] = *(const u32x4*)(grow + bj * HALF); }
#pragma unroll
        for (int ai = 0; ai < 2; ++ai)
#pragma unroll
            for (int m = 0; m < 4; ++m) { bf16_t* brow = mb + (size_t)(row0 + ai * HALF + m * 16) * 1024 + col0;
#pragma unroll
                for (int bj = 0; bj < 2; ++bj) { const u32x4 gw = gwv[ai][m][bj]; u32x4 w;
#pragma unroll
                    for (int n = 0; n < 2; ++n) { const unsigned lo = gw[2 * n], hi_ = gw[2 * n + 1];
                        f32x4 g; g[0] = __uint_as_float(lo << 16); g[1] = __uint_as_float(lo & 0xffff0000u); g[2] = __uint_as_float(hi_ << 16); g[3] = __uint_as_float(hi_ & 0xffff0000u);
                        const f32x4 v = acc[ai][bj][m][n] * g; acc[ai][bj][m][n] = v;
                        w[2 * n] = cvt_pk_bf16(v[0], v[1]); w[2 * n + 1] = cvt_pk_bf16(v[2], v[3]); }
                    if (i == 3) *(u32x4*)(brow + bj * HALF) = w; } }
    }
};
__device__ __forceinline__ float dpp_ror1(float x) { return __builtin_bit_cast(float, __builtin_amdgcn_update_dpp(0, __builtin_bit_cast(int, x), 0x121, 0xf, 0xf, false)); }
__device__ __forceinline__ float dpp_ror15(float x) { return __builtin_bit_cast(float, __builtin_amdgcn_update_dpp(0, __builtin_bit_cast(int, x), 0x12F, 0xf, 0xf, false)); }
struct EpiFfn {
    static constexpr bool PERM = true, AFTER_DRAIN = false, KEEP_ACC = false;
    bf16_t* act; float* edge; const float* ssq; const float* cw; const float* cb; int nblk;
    __device__ __forceinline__ void operator()(const f32x4 (&acc)[2][2][4][2], const Unit& u, int wr, int wc, int fr, int fq) const {
        typedef unsigned u32x2 __attribute__((ext_vector_type(2)));
        { const int t_ = otid(), l_ = t_ & 63, w_ = t_ >> 6; wr = w_ >> 2; wc = w_ & 3; fr = l_ & 15; fq = l_ >> 4; }
        const int row0 = u.pm * BM + wr * 64 + fr; const int ch0 = u.pn * 128 + wc * 32 + 8 * fq;
        constexpr bool r1up = true;
        const size_t esz = (size_t)nblk * 2 * 2816;
        float rs8[2][4]; rows_rstd8(ssq, row0, fq, rs8);
        f32x4 cwv[2][4];
#pragma unroll
        for (int n = 0; n < 2; ++n) { const int ch = ch0 + 4 * n; cwv[n][0] = *(const f32x4*)(cw + ch); cwv[n][1] = *(const f32x4*)(cw + 2816 + ch); cwv[n][2] = *(const f32x4*)(cw + 2 * 2816 + ch); cwv[n][3] = *(const f32x4*)(cb + ch); }
#pragma unroll
        for (int ai = 0; ai < 2; ++ai) {
            const int blk = (u.pm * BM + ai * HALF + wr * 64) >> 6;
            f32x4 ua_prev[2], db_next[2], gcur[2];
#pragma unroll
            for (int n = 0; n < 2; ++n) { gcur[n] = acc[ai][1][0][n] * rs8[ai][0]; ua_prev[n] = (f32x4){0.f, 0.f, 0.f, 0.f};
#pragma unroll
                for (int j = 0; j < 4; ++j) db_next[n][j] = dpp_ror15(gcur[n][j]); }
#pragma unroll
            for (int m = 0; m < 4; ++m) { f32x4 ua[2], db[2], gnext[2]; u32x4 w4; f32x4 cvs[2], uus[2];
                const bool isF = (m == 0) && (fr == 0), isL = (m == 3) && (fr == 15);
#pragma unroll
                for (int n = 0; n < 2; ++n) { db[n] = db_next[n];
#pragma unroll
                    for (int j = 0; j < 4; ++j) ua[n][j] = dpp_ror1(gcur[n][j]);
                    if (m < 3) { gnext[n] = acc[ai][1][m < 3 ? m + 1 : 3][n] * rs8[ai][m < 3 ? m + 1 : 3];
#pragma unroll
                        for (int j = 0; j < 4; ++j) db_next[n][j] = dpp_ror15(gnext[n][j]); }
                    else { gnext[n] = (f32x4){0.f, 0.f, 0.f, 0.f}; db_next[n] = gnext[n]; }
                    const f32x4 w0 = cwv[n][0], w1 = cwv[n][1], w2 = cwv[n][2], bb = cwv[n][3]; const f32x4 uu = acc[ai][0][m][n] * rs8[ai][m]; f32x4 cv;
#pragma unroll
                    for (int j = 0; j < 4; ++j) { const float up = (fr > 0) ? ua[n][j] : ua_prev[n][j]; const float dn = (fr < 15) ? db[n][j] : db_next[n][j];
                        cv[j] = w0[j] * up + w1[j] * gcur[n][j] + w2[j] * dn + bb[j]; }
                    cvs[n] = cv; uus[n] = uu;
                    f32x4 a4;
#pragma unroll
                    for (int j = 0; j < 4; ++j) a4[j] = cv[j] * sigm(cv[j]) * uu[j];
                    w4[2 * n] = cvt_pk_bf16(a4[0], a4[1]); w4[2 * n + 1] = cvt_pk_bf16(a4[2], a4[3]); }
                if (isF || isL) { float* e = edge + ((size_t)blk * 2 + (isL ? 1 : 0)) * 2816 + ch0;
#pragma unroll
                    for (int n = 0; n < 2; ++n) { *(f32x4*)(e + 4 * n) = cvs[n]; *(f32x4*)(e + esz + 4 * n) = uus[n]; *(f32x4*)(e + 2 * esz + 4 * n) = gcur[n]; } }
                else *(u32x4*)(act + (size_t)(row0 + ai * HALF + m * 16) * 2816 + ch0) = w4;
#pragma unroll
                for (int n = 0; n < 2; ++n) { ua_prev[n] = ua[n]; gcur[n] = gnext[n]; }
            }
            asm volatile("" ::: "memory");
        }
    }
};
struct EpiResid {
    static constexpr bool PERM = true, AFTER_DRAIN = false, KEEP_ACC = false;
    bf16_t* xr; float* ssq;
    __device__ __forceinline__ void operator()(const f32x4 (&acc)[2][2][4][2], const Unit& u, int wr, int wc, int fr, int fq) const {
        const int row0 = u.pm * BM + wr * 64 + fr; const int col0 = u.pn * BM + wc * 32 + 8 * fq;
        u32x4 owv[2][4][2];
#pragma unroll
        for (int ai = 0; ai < 2; ++ai)
#pragma unroll
            for (int m = 0; m < 4; ++m) { const bf16_t* xp = xr + (size_t)(row0 + ai * HALF + m * 16) * 1024 + col0;
#pragma unroll
                for (int bj = 0; bj < 2; ++bj) owv[ai][m][bj] = *(const u32x4*)(xp + bj * HALF); }
#pragma unroll
        for (int ai = 0; ai < 2; ++ai)
#pragma unroll
            for (int m = 0; m < 4; ++m) { const int row = row0 + ai * HALF + m * 16; bf16_t* xp = xr + (size_t)row * 1024 + col0; float sq = 0.f;
#pragma unroll
                for (int bj = 0; bj < 2; ++bj) { const u32x4 ow = owv[ai][m][bj]; u32x4 w;
#pragma unroll
                    for (int n = 0; n < 2; ++n) { f32x4 v = acc[ai][bj][m][n]; const unsigned lo = ow[2 * n], hi_ = ow[2 * n + 1];
                        v[0] += __uint_as_float(lo << 16); v[1] += __uint_as_float(lo & 0xffff0000u); v[2] += __uint_as_float(hi_ << 16); v[3] += __uint_as_float(hi_ & 0xffff0000u);
                        sq += (v[0] * v[0] + v[1] * v[1]) + (v[2] * v[2] + v[3] * v[3]);
                        w[2 * n] = cvt_pk_bf16(v[0], v[1]); w[2 * n + 1] = cvt_pk_bf16(v[2], v[3]); }
                    *(u32x4*)(xp + bj * HALF) = w; }
                sq += __shfl_xor(sq, 16); sq += __shfl_xor(sq, 32);
                if (fq == 0) ssq[(size_t)row * 16 + u.pn * 4 + wc] = sq; }
    }
};
struct BranchOrder {
    int nM, G, c;
    __device__ bool next(int i, Unit& u) const { const int tl = (i >> 2) * G + c; if (tl >= nM * 4) return false; const int sub = i & 3; u.pm = sub * nM + (tl >> 2); u.pn = sub * 4 + (tl & 3); return true; }
    __device__ __forceinline__ void a_ready(const Unit&) const {}
    __device__ __forceinline__ void done(const Unit&) const {}
};

template <class Epi, class Sched, bool ALIGN_EPI = false, bool SP2 = false>
__device__ __forceinline__ void gemm_phase(PG8_LAS unsigned char* lds, const Gemm g, const Sched& S, const Epi& E) {
    const int tid = otid(), wid = __builtin_amdgcn_readfirstlane(tid >> 6), lane = tid & 63, wr = wid >> 2, wc = wid & 3, fr = lane & 15, fq = lane >> 4;
    const int K = g.K, nt = K / BK;
    unsigned voffA[2], voffB[2];
#pragma unroll
    for (int i = 0; i < 2; ++i) { int R, C; stage_rc(tid * 16 + i * 8192, R, C); const int Rb = Epi::PERM ? ((R & ~31) + perm32(R & 31)) : R;
        voffA[i] = (unsigned)(R * K + C) * 2u; voffB[i] = (unsigned)(Rb * K + C) * 2u; }
    const size_t kstep = (size_t)(BK * 2);
    const size_t hstep = (size_t)HALF * K * 2;
    const size_t tstep = 2 * hstep;
    const unsigned ldsw = (unsigned)wid * 1024u;
    const int aoff = lds_byte(wr * 64 + fr, fq * 8), boff = lds_byte(wc * 32 + fr, fq * 8);
#define PG8_SA(b, h) (((b) * 2 + (h)) * HTB)
#define PG8_SB(b, h) ((4 + (b) * 2 + (h)) * HTB)
#define PG8_STAGE(bufoff, gbase, voff) do { _Pragma("unroll") for (int _i = 0; _i < 2; ++_i) \
        __builtin_amdgcn_global_load_lds((const unsigned*)((const char*)(gbase) + (voff)[_i]), (PG8_LAS unsigned*)(lds + (bufoff) + ldsw + _i * 8192), 16, 0, 0); } while (0)
#define PG8_LDA(dst, b, h) do { _Pragma("unroll") for (int m = 0; m < 4; ++m) _Pragma("unroll") for (int k = 0; k < 2; ++k) dst[m][k] = *(const PG8_LAS bf16x8*)(lds + PG8_SA(b, h) + aoff + m * 2048 + k * 1024); } while (0)
#define PG8_LDB(dst, b, h) do { _Pragma("unroll") for (int n = 0; n < 2; ++n) _Pragma("unroll") for (int k = 0; k < 2; ++k) dst[n][k] = *(const PG8_LAS bf16x8*)(lds + PG8_SB(b, h) + boff + n * 2048 + k * 1024); } while (0)
#define PG8_MMA(ai, bj, At, Bt) do { __builtin_amdgcn_s_setprio(1); _Pragma("unroll") for (int m = 0; m < 4; ++m) _Pragma("unroll") for (int n = 0; n < 2; ++n) _Pragma("unroll") for (int k = 0; k < 2; ++k) \
        acc[ai][bj][m][n] = __builtin_amdgcn_mfma_f32_16x16x32_bf16(Bt[n][k], At[m][k], acc[ai][bj][m][n], 0, 0, 0); __builtin_amdgcn_s_setprio(0); } while (0)
#define PG8_WAIT_V(n) asm volatile("s_waitcnt vmcnt(" #n ")" ::: "memory")
#define PG8_WAIT_L(n) asm volatile("s_waitcnt lgkmcnt(" #n ")" ::: "memory")
#define PG8_BAR __builtin_amdgcn_s_barrier()
#define PG8_SCHED __builtin_amdgcn_sched_barrier(0)
    Unit cur, nxt; int ui = 0;
    if (!S.next(0, cur)) return;
    f32x4 acc[2][2][4][2];
#pragma unroll
    for (int a = 0; a < 2; ++a)
#pragma unroll
        for (int b = 0; b < 2; ++b)
#pragma unroll
            for (int m = 0; m < 4; ++m)
#pragma unroll
                for (int n = 0; n < 2; ++n) acc[a][b][m][n] = (f32x4){0.f, 0.f, 0.f, 0.f};
    bf16x8 At[4][2], B0[2][2], B1[2][2];
    const char* cA = (const char*)g.A + (size_t)cur.pm * tstep; const char* cB = (const char*)g.Bt + (size_t)cur.pn * tstep;
    S.a_ready(cur);
    if constexpr (SP2) {
        PG8_STAGE(PG8_SB(0, 0), cB, voffB); PG8_STAGE(PG8_SB(0, 1), cB + hstep, voffB); PG8_STAGE(PG8_SA(0, 0), cA, voffA); PG8_STAGE(PG8_SA(0, 1), cA + hstep, voffA);
        if (wr == 1) PG8_BAR;
        PG8_WAIT_V(2); PG8_BAR;
        PG8_STAGE(PG8_SB(1, 0), cB + kstep, voffB); PG8_STAGE(PG8_SA(1, 0), cA + kstep, voffA); PG8_STAGE(PG8_SB(1, 1), cB + hstep + kstep, voffB);
        PG8_WAIT_V(6); PG8_BAR;
    } else {
        PG8_STAGE(PG8_SB(0, 0), cB, voffB); PG8_STAGE(PG8_SA(0, 0), cA, voffA); PG8_STAGE(PG8_SB(0, 1), cB + hstep, voffB); PG8_STAGE(PG8_SA(0, 1), cA + hstep, voffA);
        if (wr == 1) PG8_BAR;
        PG8_WAIT_V(4); PG8_BAR;
        PG8_STAGE(PG8_SB(1, 0), cB + kstep, voffB); PG8_STAGE(PG8_SA(1, 0), cA + kstep, voffA); PG8_STAGE(PG8_SB(1, 1), cB + hstep + kstep, voffB);
        PG8_WAIT_V(6); PG8_BAR;
    }
    for (;;) {
        const bool has_next = S.next(ui + 1, nxt);
        const char* nA = has_next ? (const char*)g.A + (size_t)nxt.pm * tstep : cA; const char* nB = has_next ? (const char*)g.Bt + (size_t)nxt.pn * tstep : cB;
        for (int t = 0; t < nt; t += 2) {
            const bool last = (t == nt - 2);
            const char* a1 = cA + (size_t)(t + 1) * kstep;
            const char* a2 = last ? nA : cA + (size_t)(t + 2) * kstep; const char* b2 = last ? nB : cB + (size_t)(t + 2) * kstep;
            const char* a3 = a2 + kstep; const char* b3 = b2 + kstep;
            if (last && has_next) S.a_ready(nxt);
            if constexpr (SP2) {
            PG8_LDB(B0, 0, 0); PG8_LDB(B1, 0, 1); PG8_SCHED; PG8_LDA(At, 0, 0); PG8_STAGE(PG8_SA(1, 1), a1 + hstep, voffA);
            PG8_WAIT_V(8); PG8_WAIT_L(0); PG8_BAR; PG8_MMA(0, 0, At, B0); PG8_MMA(0, 1, At, B1); PG8_BAR; PG8_SCHED;
            PG8_LDA(At, 0, 1); PG8_STAGE(PG8_SB(0, 0), b2, voffB); PG8_STAGE(PG8_SB(0, 1), b2 + hstep, voffB); PG8_STAGE(PG8_SA(0, 0), a2, voffA);
            PG8_WAIT_V(8); PG8_WAIT_L(0); PG8_BAR; PG8_MMA(1, 0, At, B0); PG8_MMA(1, 1, At, B1); PG8_BAR; PG8_SCHED;
            PG8_LDB(B0, 1, 0); PG8_LDB(B1, 1, 1); PG8_SCHED; PG8_LDA(At, 1, 0); PG8_STAGE(PG8_SA(0, 1), a2 + hstep, voffA);
            PG8_WAIT_V(8); PG8_WAIT_L(0); PG8_BAR; PG8_MMA(0, 0, At, B0); PG8_MMA(0, 1, At, B1); PG8_BAR; PG8_SCHED;
            PG8_LDA(At, 1, 1); PG8_STAGE(PG8_SB(1, 0), b3, voffB); PG8_STAGE(PG8_SB(1, 1), b3 + hstep, voffB); PG8_STAGE(PG8_SA(1, 0), a3, voffA);
            PG8_WAIT_V(8); PG8_WAIT_L(0); PG8_BAR; PG8_MMA(1, 0, At, B0); PG8_MMA(1, 1, At, B1); PG8_BAR; PG8_SCHED;
            } else {
            PG8_LDB(B0, 0, 0); PG8_SCHED; PG8_LDA(At, 0, 0); PG8_STAGE(PG8_SA(1, 1), a1 + hstep, voffA);
            PG8_WAIT_L(8); PG8_BAR; PG8_WAIT_L(0); PG8_MMA(0, 0, At, B0); PG8_BAR; PG8_SCHED;
            PG8_LDB(B1, 0, 1); PG8_STAGE(PG8_SB(0, 0), b2, voffB);
            PG8_BAR; PG8_WAIT_L(0); PG8_MMA(0, 1, At, B1); PG8_BAR;
            PG8_LDA(At, 0, 1); PG8_STAGE(PG8_SA(0, 0), a2, voffA);
            PG8_BAR; PG8_WAIT_L(0); PG8_MMA(1, 0, At, B0); PG8_BAR; PG8_SCHED;
            PG8_STAGE(PG8_SB(0, 1), b2 + hstep, voffB);
            PG8_WAIT_V(6); PG8_BAR; PG8_MMA(1, 1, At, B1); PG8_BAR;
            PG8_LDB(B0, 1, 0); PG8_SCHED; PG8_LDA(At, 1, 0); PG8_STAGE(PG8_SA(0, 1), a2 + hstep, voffA);
            PG8_WAIT_L(8); PG8_BAR; PG8_WAIT_L(0); PG8_MMA(0, 0, At, B0); PG8_BAR; PG8_SCHED;
            PG8_LDB(B1, 1, 1); PG8_STAGE(PG8_SB(1, 0), b3, voffB);
            PG8_BAR; PG8_WAIT_L(0); PG8_MMA(0, 1, At, B1); PG8_BAR;
            PG8_LDA(At, 1, 1); PG8_STAGE(PG8_SA(1, 0), a3, voffA);
            PG8_BAR; PG8_WAIT_L(0); PG8_MMA(1, 0, At, B0); PG8_BAR; PG8_SCHED;
            PG8_STAGE(PG8_SB(1, 1), b3 + hstep, voffB);
            PG8_WAIT_V(6); PG8_BAR; PG8_MMA(1, 1, At, B1); PG8_BAR;
            }
        }
        if constexpr (ALIGN_EPI) { if (wr == 0) PG8_BAR; }
        if constexpr (!Epi::AFTER_DRAIN) { E(acc, cur, wr, wc, fr, fq); S.done(cur); }
        if (!has_next) break;
        if (!Epi::KEEP_ACC || ((ui + 1) & 3) == 0) {
#pragma unroll
        for (int a = 0; a < 2; ++a)
#pragma unroll
            for (int b = 0; b < 2; ++b)
#pragma unroll
                for (int m = 0; m < 4; ++m)
#pragma unroll
                    for (int n = 0; n < 2; ++n) acc[a][b][m][n] = (f32x4){0.f, 0.f, 0.f, 0.f};
        }
        cur = nxt; cA = nA; cB = nB; ++ui;
        if constexpr (ALIGN_EPI) { if (wr == 1) PG8_BAR; }
    }
    PG8_WAIT_V(0);
    if constexpr (!ALIGN_EPI) { if (wr == 0) PG8_BAR; }
    PG8_BAR;
    if constexpr (Epi::AFTER_DRAIN) { E.fused(acc, cur, wr, wc, fr, fq, lds, wid, lane); S.done(cur); }
#undef PG8_SA
#undef PG8_SB
#undef PG8_STAGE
#undef PG8_LDA
#undef PG8_LDB
#undef PG8_MMA
#undef PG8_WAIT_V
#undef PG8_WAIT_L
#undef PG8_BAR
#undef PG8_SCHED
}
}
#define LAS __attribute__((address_space(3)))
typedef unsigned short bf16_t;
typedef short bf16x8 __attribute__((ext_vector_type(8)));
typedef short v4i16_t __attribute__((ext_vector_type(4)));
typedef float f32x4 __attribute__((ext_vector_type(4)));
typedef float f32x16 __attribute__((ext_vector_type(16)));
typedef unsigned u32x4 __attribute__((ext_vector_type(4)));
typedef unsigned u32x2 __attribute__((ext_vector_type(2)));
using pg8::cvt_pk_bf16;

constexpr int DM = 1024, SEQ = 2048, NSEQ = 40, NTOK_P = 32 * SEQ, NTOK = NSEQ * SEQ, DEPTH = 2;
constexpr int TMAX = 32768, NGROUP = 3;
constexpr int NPROJ = 6656;
constexpr int PPITCH = 2560;
constexpr int PA = 0, PB = 768, PD = 1536, PC = 2048, PG = 2560;
constexpr int FF = 2816, NUG = 2 * FF;
constexpr float EPS = 1e-6f, LOG2E = 1.4426950408889634f;
constexpr int NWAVES = 8, NTHR = 512;

constexpr size_t al256(size_t x) { return (x + 255) & ~(size_t)255; }
constexpr size_t WS_WIN = 1 << 20;
constexpr size_t WS_WBR = WS_WIN + al256((size_t)DEPTH * NPROJ * DM * 2);
constexpr size_t WS_WOUT = WS_WBR + al256((size_t)DEPTH * 4 * 1024 * 256 * 2);
constexpr size_t WS_WFI = WS_WOUT + al256((size_t)DEPTH * DM * DM * 2);
constexpr size_t WS_WFO = WS_WFI + al256((size_t)DEPTH * NUG * DM * 2);
constexpr size_t WS_WUQ = WS_WFO + al256((size_t)DEPTH * DM * FF * 2);
constexpr size_t WS_WUKV = WS_WUQ + al256((size_t)DEPTH * 384 * 192 * 2);
constexpr size_t WS_ROPE = WS_WUKV + al256((size_t)DEPTH * 512 * 128 * 2);
constexpr size_t WS_XN = WS_ROPE + al256((size_t)2048 * 16 * 8);
constexpr size_t WS_PROJ = WS_XN + al256((size_t)TMAX * DM * 2);
constexpr size_t WS_RAT = WS_PROJ + al256((size_t)TMAX * PPITCH * 2);
constexpr size_t WS_QC = WS_RAT + al256((size_t)4 * TMAX * 1024 * 2);
constexpr size_t WS_KC = WS_QC + al256((size_t)TMAX * 384 * 2);
constexpr size_t WS_VC = WS_KC + al256((size_t)TMAX * 384 * 2);
constexpr size_t WS_OB = WS_VC + al256((size_t)TMAX * 256 * 2);
constexpr size_t WS_MRG = WS_OB + al256((size_t)4 * TMAX * 256 * 2);
constexpr size_t WS_MB = WS_MRG + al256((size_t)48 << 20);
constexpr size_t WS_UG = WS_MB + al256((size_t)TMAX * DM * 2);
constexpr size_t WS_ACT = WS_UG;
constexpr size_t WS_END = WS_ACT + al256((size_t)TMAX * FF * 2);
static_assert(WS_END <= ((size_t)1 << 30), "workspace map exceeds 1 GiB");
static_assert((size_t)64 * TMAX * 4 + (size_t)3 * (TMAX / 64) * 2 * 2816 * 4 <= ((size_t)48 << 20), "MRG region");

constexpr int LDS_BYTES = 135168;

struct Args { const float* in[24]; float* out; unsigned char* ws; };
#ifndef PH_MASK
#define PH_MASK 0xFFFF
#endif
#ifndef FLK
#define FLK 15
#endif
#ifndef DUP_MASK
#define DUP_MASK 0
#endif
#define PH(k) _Pragma("unroll 1") for (int rep_ = 0; rep_ < (int)(((PH_MASK >> (k)) & 1) + ((DUP_MASK >> (k)) & 1)); ++rep_)

__device__ __forceinline__ float bf2f(bf16_t b) { return __uint_as_float((unsigned)b << 16); }
__device__ __forceinline__ bf16_t f2bf(float f) { return (bf16_t)(cvt_pk_bf16(f, 0.f) & 0xffffu); }
__device__ __forceinline__ float wave_sum(float v) {
#pragma unroll
    for (int o = 1; o < 64; o <<= 1) v += __shfl_xor(v, o);
    return v;
}
__device__ __forceinline__ int crow(int r, int hi) { return (r & 3) + 8 * (r >> 2) + 4 * hi; }
__device__ __forceinline__ v4i16_t vtr(LAS const char* p) { return __builtin_amdgcn_ds_read_tr16_b64_v4i16((LAS v4i16_t*)p); }
#define MFMA32(a, b, c) __builtin_amdgcn_mfma_f32_32x32x16_bf16((a), (b), (c), 0, 0, 0)
#define MFMA16(a, b, c) __builtin_amdgcn_mfma_f32_16x16x32_bf16((a), (b), (c), 0, 0, 0)

__device__ __forceinline__ void transpose_item(const float* W, int K, int N, bf16_t* WT, int n0d, int n0s, float scale, int k0, float* scr, int lane, bool gperm = false, const float* kgain = nullptr) {
    if (gperm) {
        const int cg = n0d - PG + (lane & 31), tg = cg >> 8, cc = cg & 255, gi = 2 * (cc >> 7) + ((cc >> 2) & 1), ch = tg * 64 + 16 * ((cc >> 5) & 3) + 4 * ((cc >> 3) & 3) + (cc & 3);
        const int src = 2400 + gi * 1024 + ch;
#pragma unroll
        for (int i = 0; i < 32; ++i) { const int kk = 2 * i + (lane >> 5); scr[kk * 33 + (lane & 31)] = W[(size_t)(k0 + kk) * N + src] * kgain[k0 + kk]; }
    } else if (n0s >= 0) {
#pragma unroll
        for (int i = 0; i < 32; ++i) { const int kk = 2 * i + (lane >> 5); scr[kk * 33 + (lane & 31)] = W[(size_t)(k0 + kk) * N + n0s + (lane & 31)] * (kgain ? scale * kgain[k0 + kk] : scale); }
    } else {
#pragma unroll
        for (int i = 0; i < 32; ++i) { const int kk = 2 * i + (lane >> 5); scr[kk * 33 + (lane & 31)] = 0.f; }
    }
    __builtin_amdgcn_wave_barrier(); asm volatile("s_waitcnt lgkmcnt(0)" ::: "memory");
    const int c = lane & 7;
#pragma unroll
    for (int j = 0; j < 4; ++j) { const int n = (lane >> 3) + 8 * j; const float* s = scr + (8 * c) * 33 + n;
        u32x4 o; o.x = cvt_pk_bf16(s[0 * 33], s[1 * 33]); o.y = cvt_pk_bf16(s[2 * 33], s[3 * 33]); o.z = cvt_pk_bf16(s[4 * 33], s[5 * 33]); o.w = cvt_pk_bf16(s[6 * 33], s[7 * 33]);
        *(u32x4*)(WT + (size_t)(n0d + n) * K + k0 + 8 * c) = o; }
    __builtin_amdgcn_wave_barrier(); asm volatile("s_waitcnt lgkmcnt(0)" ::: "memory");
}
__device__ __forceinline__ void prologue(const Args& a, unsigned char* ws, char* lds, int gw, int NGW, int wave, int lane) {
    float* scr = (float*)(lds + wave * 16384);
    constexpr int I_IN = 16 * (NPROJ / 32), I_BR = 4 * 4 * 32, I_OUT = 16 * 32, I_FI = 16 * (NUG / 32), I_FO = (FF / 64) * 32, I_UQ = 3 * 12, I_UKV = 2 * 16;
    constexpr int PER_L = I_IN + I_BR + I_OUT + I_FI + I_FO + I_UQ + I_UKV;
    for (int it = gw; it < DEPTH * PER_L; it += NGW) {
        const int l = it / PER_L; int r = it % PER_L;
        if (r < I_IN) { const int nb = r % (NPROJ / 32), kb = r / (NPROJ / 32); const int n0d = nb * 32; int n0s; float sc = 1.f;
            if (n0d < PD) { n0s = n0d; if (n0d < 256) sc = 0.17677669529663687f * LOG2E; else if (n0d >= PB && n0d < PB + 256) sc = 0.125f * LOG2E; }
            else if (n0d < PC) n0s = n0d - PD + 1888;
            else if (n0d < PC + 352) n0s = n0d - PC + 1536;
            else if (n0d < PG) n0s = -1;
            else n0s = n0d - PG + 2400;
            transpose_item(a.in[3] + (size_t)l * DM * 6496, DM, 6496, (bf16_t*)(ws + WS_WIN) + (size_t)l * NPROJ * DM, n0d, n0s, sc, kb * 64, scr, lane, n0d >= PG, a.in[2] + l * DM); continue; }
        r -= I_IN;
        if (r < I_BR) { const int i = r / 128, rr = r % 128, nb = rr % 32, kb = rr / 32;
            transpose_item(a.in[16] + ((size_t)l * 4 + i) * 256 * 1024, 256, 1024, (bf16_t*)(ws + WS_WBR) + ((size_t)l * 4 + i) * 1024 * 256, nb * 32, nb * 32, 1.f, kb * 64, scr, lane); continue; }
        r -= I_BR;
        if (r < I_OUT) { const int nb = r % 32, kb = r / 32;
            transpose_item(a.in[17] + (size_t)l * DM * DM, DM, DM, (bf16_t*)(ws + WS_WOUT) + (size_t)l * DM * DM, nb * 32, nb * 32, 1.f, kb * 64, scr, lane); continue; }
        r -= I_OUT;
        if (r < I_FI) { const int nb = r % (NUG / 32), kb = r / (NUG / 32);
            const int n0d = nb * 32, src0 = ((n0d >> 7) & 1) * FF + (n0d >> 8) * 128 + (n0d & 127);
            transpose_item(a.in[19] + (size_t)l * DM * NUG, DM, NUG, (bf16_t*)(ws + WS_WFI) + (size_t)l * NUG * DM, n0d, src0, 1.f, kb * 64, scr, lane, false, a.in[18] + l * DM); continue; }
        r -= I_FI;
        if (r < I_FO) { const int nb = r % 32, kb = r / 32;
            transpose_item(a.in[22] + (size_t)l * FF * DM, FF, DM, (bf16_t*)(ws + WS_WFO) + (size_t)l * DM * FF, nb * 32, nb * 32, 1.f, kb * 64, scr, lane); continue; }
        r -= I_FO;
        if (r < I_UQ) { const int nb = r % 12, kb = r / 12;
            transpose_item(a.in[12] + (size_t)l * 192 * 384, 192, 384, (bf16_t*)(ws + WS_WUQ) + (size_t)l * 384 * 192, nb * 32, nb * 32, 1.f, kb * 64, scr, lane); continue; }
        r -= I_UQ;
        { const int nb = r % 16, kb = r / 16;
            transpose_item(a.in[13] + (size_t)l * 128 * 512, 128, 512, (bf16_t*)(ws + WS_WUKV) + (size_t)l * 512 * 128, nb * 32, nb * 32, 1.f, kb * 64, scr, lane); }
    }
    float2* rope = (float2*)(ws + WS_ROPE);
    for (int e = gw * 64 + lane; e < 2048 * 16; e += NGW * 64) {
        const int pos = e >> 4, i = e & 15;
        const float inv = exp2f(-(float)i * (13.287712379549449f / 16.0f));
        const float ang = (float)pos * inv;
        const double rev = (double)ang * 0.15915494309189535; const double fr = rev - __builtin_rint(rev);
        rope[e] = make_float2(__builtin_amdgcn_cosf((float)fr), __builtin_amdgcn_sinf((float)fr));
    }
}

__device__ __forceinline__ void convert_phase(const float* xa, const float* xb, int row_g0, int T, bf16_t* XR, float* S0, int gw, int NGW, int lane) {
#pragma unroll 1
    for (int m0 = gw; m0 < T; m0 += 2 * NGW) { const int m1 = (m0 + NGW < T) ? m0 + NGW : m0;
        f32x4 v[2][4];
#pragma unroll
        for (int k = 0; k < 2; ++k) { const int R = row_g0 + (k ? m1 : m0); const float* xr = (R < NTOK_P) ? xa + (size_t)R * DM : xb + (size_t)(R - NTOK_P) * DM;
#pragma unroll
            for (int j = 0; j < 4; ++j) v[k][j] = __builtin_nontemporal_load(((const f32x4*)xr) + lane + 64 * j); }
#pragma unroll
        for (int k = 0; k < 2; ++k) { const int m = k ? m1 : m0; float s = 0.f;
#pragma unroll
            for (int j = 0; j < 4; ++j) s += (v[k][j].x * v[k][j].x + v[k][j].y * v[k][j].y) + (v[k][j].z * v[k][j].z + v[k][j].w * v[k][j].w);
            s = wave_sum(s);
            u32x2* o8 = (u32x2*)(XR + (size_t)m * DM);
#pragma unroll
            for (int j = 0; j < 4; ++j) { u32x2 w; w.x = cvt_pk_bf16(v[k][j].x, v[k][j].y); w.y = cvt_pk_bf16(v[k][j].z, v[k][j].w); o8[lane + 64 * j] = w; }
            if (lane < 16) S0[(size_t)m * 16 + lane] = (lane == 0) ? s : 0.f; }
    }
}
__device__ __forceinline__ void final_norm_phase(float* out, int row_g0, int T, const bf16_t* XR, const float* S0, const float* gain, int gw, int NGW, int lane) {
    f32x4 g[4];
#pragma unroll
    for (int j = 0; j < 4; ++j) g[j] = ((const f32x4*)gain)[lane + 64 * j];
#pragma unroll 1
    for (int m0 = gw; m0 < T; m0 += 2 * NGW) { const int m1 = (m0 + NGW < T) ? m0 + NGW : m0;
        u32x2 w[2][4]; f32x4 sp[2][4];
#pragma unroll
        for (int k = 0; k < 2; ++k) { const int m = k ? m1 : m0; const u32x2* x8 = (const u32x2*)(XR + (size_t)m * DM);
#pragma unroll
            for (int j = 0; j < 4; ++j) { w[k][j] = x8[lane + 64 * j]; sp[k][j] = ((const f32x4*)(S0 + (size_t)m * 16))[j]; } }
#pragma unroll
        for (int k = 0; k < 2; ++k) { const int m = k ? m1 : m0; float* orow = out + (size_t)(row_g0 + m) * DM;
            const float sq_ = (((sp[k][0][0] + sp[k][0][1]) + (sp[k][0][2] + sp[k][0][3])) + ((sp[k][1][0] + sp[k][1][1]) + (sp[k][1][2] + sp[k][1][3]))) + (((sp[k][2][0] + sp[k][2][1]) + (sp[k][2][2] + sp[k][2][3])) + ((sp[k][3][0] + sp[k][3][1]) + (sp[k][3][2] + sp[k][3][3])));
            const float rstd = 1.0f / sqrtf(sq_ * (1.f / DM) + EPS);
#pragma unroll
            for (int j = 0; j < 4; ++j) { f32x4 v; v.x = __uint_as_float(w[k][j].x << 16) * rstd * g[j].x; v.y = __uint_as_float(w[k][j].x & 0xffff0000u) * rstd * g[j].y; v.z = __uint_as_float(w[k][j].y << 16) * rstd * g[j].z; v.w = __uint_as_float(w[k][j].y & 0xffff0000u) * rstd * g[j].w;
                __builtin_nontemporal_store(v, ((f32x4*)orow) + lane + 64 * j); } }
    }
}
__device__ __forceinline__ void conv_fix_phase(const float* edge, bf16_t* ACT, const float* cw, int T, int gtid, int NT) {
    constexpr int NCH = FF / 8; const int NBLK = T / 64; const size_t esz = (size_t)NBLK * 2 * FF;
#pragma unroll 1
    for (int idx = gtid; idx < NBLK * 2 * NCH; idx += NT) { const int ch = (idx % NCH) * 8, bw = idx / NCH, which = bw & 1, blk = bw >> 1;
        const int row = blk * 64 + (which ? 63 : 0), pos = row & (SEQ - 1);
        const bool nb_ok = which ? (pos < SEQ - 1) : (pos > 0);
        const float* e = edge + (size_t)bw * FF + ch; const float* wv = cw + (which ? 2 * FF : 0) + ch;
        const float* gn = edge + 2 * esz + (size_t)(which ? (blk + 1) * 2 : (blk - 1) * 2 + 1) * FF + ch;
        u32x4 o;
#pragma unroll
        for (int q = 0; q < 2; ++q) { const f32x4 cv = ((const f32x4*)e)[q], uu = ((const f32x4*)(e + esz))[q], wq = ((const f32x4*)wv)[q]; f32x4 gq = {0.f, 0.f, 0.f, 0.f}; if (nb_ok) gq = ((const f32x4*)gn)[q];
            float r[4];
#pragma unroll
            for (int j = 0; j < 4; ++j) { const float c = cv[j] + wq[j] * gq[j]; r[j] = c * pg8::sigm(c) * uu[j]; }
            o[2 * q] = cvt_pk_bf16(r[0], r[1]); o[2 * q + 1] = cvt_pk_bf16(r[2], r[3]); }
        *(u32x4*)(ACT + (size_t)row * FF + ch) = o; }
}

template <int NTK>
__device__ __forceinline__ void pp_elem(const int (&toks)[NTK], bf16_t* PROJ, bf16_t* KC, const float2* rope, const float* dqn, const float* dkn, int lane) {
    int e0, c, sec = 0; bool isD = false; float sc = 1.f; const float* gn = dqn;
    if (lane < 32) { sec = lane >> 1; c = lane & 1; e0 = PA + sec * 32 + c * 8; }
    else if (lane < 56) { const int t = lane - 32, hd = t >> 2; sec = (t >> 1) & 1; c = t & 1; e0 = PD + hd * 64 + sec * 32 + c * 8; isD = true; gn = ((hd < 4) ? dqn : dkn) + sec * 32 + c * 8; sc = (hd < 4) ? 0.125f * LOG2E : 1.f; }
    else { c = lane & 1; e0 = PC + 320 + c * 8; }
    const bool active = lane < 58, isC = lane >= 56;
    u32x4 xa[NTK], xb[NTK]; f32x4 rp[NTK][4];
#pragma unroll
    for (int k = 0; k < NTK; ++k) { const int tok = toks[k], pos = tok & (SEQ - 1); const bf16_t* row = PROJ + (size_t)tok * PPITCH + e0;
        const int pe = isD ? (sec ? (pos & 63) : (pos >> 6)) : pos; const f32x4* rq = (const f32x4*)(rope + pe * 16 + c * 8);
        if (active) { xa[k] = *(const u32x4*)row; xb[k] = *(const u32x4*)(row + 16); } else { xa[k] = (u32x4){0u, 0u, 0u, 0u}; xb[k] = xa[k]; }
#pragma unroll
        for (int q = 0; q < 4; ++q) rp[k][q] = rq[q]; }
    f32x4 g1[2], g2[2];
#pragma unroll
    for (int q = 0; q < 2; ++q) { g1[q] = *(const f32x4*)(gn + 4 * q); g2[q] = *(const f32x4*)(gn + 16 + 4 * q); }
#pragma unroll
    for (int k = 0; k < NTK; ++k) { const int tok = toks[k];
        float x1[8], x2[8]; float ss = 0.f;
#pragma unroll
        for (int q = 0; q < 4; ++q) { x1[2 * q] = __uint_as_float(xa[k][q] << 16); x1[2 * q + 1] = __uint_as_float(xa[k][q] & 0xffff0000u); x2[2 * q] = __uint_as_float(xb[k][q] << 16); x2[2 * q + 1] = __uint_as_float(xb[k][q] & 0xffff0000u); }
#pragma unroll
        for (int j = 0; j < 8; ++j) ss += x1[j] * x1[j] + x2[j] * x2[j];
        ss += __shfl_xor(ss, 1); ss += __shfl_xor(ss, 2);
        if (isD) { const float rstd = 1.0f / sqrtf(ss * (1.f / 64.f) + EPS);
#pragma unroll
            for (int j = 0; j < 8; ++j) { x1[j] *= rstd * g1[j >> 2][j & 3]; x2[j] *= rstd * g2[j >> 2][j & 3]; } }
        u32x4 oa, ob;
#pragma unroll
        for (int q = 0; q < 4; ++q) { const float c0 = rp[k][q][0], s0 = rp[k][q][1], c1 = rp[k][q][2], s1 = rp[k][q][3];
            oa[q] = cvt_pk_bf16((x1[2 * q] * c0 - x2[2 * q] * s0) * sc, (x1[2 * q + 1] * c1 - x2[2 * q + 1] * s1) * sc);
            ob[q] = cvt_pk_bf16((x2[2 * q] * c0 + x1[2 * q] * s0) * sc, (x2[2 * q + 1] * c1 + x1[2 * q + 1] * s1) * sc); }
        if (active) {
            if (isC) { bf16_t* kc = KC + (size_t)tok * 384 + 64 + c * 8;
#pragma unroll
                for (int hh = 0; hh < 4; ++hh) { *(u32x4*)(kc + hh * 96) = oa; *(u32x4*)(kc + hh * 96 + 16) = ob; } }
            else { bf16_t* row = PROJ + (size_t)tok * PPITCH + e0; *(u32x4*)row = oa; *(u32x4*)(row + 16) = ob; } }
    }
}
__device__ __forceinline__ void pp_mla(int tok0, int hp, const bf16_t* PROJ, bf16_t* QC, bf16_t* KC, bf16_t* VC, const float2* rope, const bf16_t* WuqT, const bf16_t* WukvT, const float* cqn, const float* ckvn, int lane) {
    const int m = lane & 15, quad = lane >> 4, tok = tok0 + m, pos = tok & (SEQ - 1);
    const bf16_t* crow_ = PROJ + (size_t)tok * PPITCH + PC;
    bf16x8 aq[6], ak[4]; float ssq_ = 0.f, ssk_ = 0.f;
#pragma unroll
    for (int ks = 0; ks < 6; ++ks) aq[ks] = *(const bf16x8*)(crow_ + ks * 32 + quad * 8);
#pragma unroll
    for (int ks = 0; ks < 4; ++ks) ak[ks] = *(const bf16x8*)(crow_ + 192 + ks * 32 + quad * 8);
#pragma unroll
    for (int ks = 0; ks < 6; ++ks)
#pragma unroll
        for (int e = 0; e < 8; ++e) { const float x = bf2f((bf16_t)aq[ks][e]); ssq_ += x * x; }
#pragma unroll
    for (int ks = 0; ks < 4; ++ks)
#pragma unroll
        for (int e = 0; e < 8; ++e) { const float x = bf2f((bf16_t)ak[ks][e]); ssk_ += x * x; }
    ssq_ += __shfl_xor(ssq_, 16); ssq_ += __shfl_xor(ssq_, 32); ssk_ += __shfl_xor(ssk_, 16); ssk_ += __shfl_xor(ssk_, 32);
    const float rq = 1.0f / sqrtf(ssq_ * (1.f / 192.f) + EPS), rk = 1.0f / sqrtf(ssk_ * (1.f / 128.f) + EPS);
#pragma unroll
    for (int ks = 0; ks < 6; ++ks) { u32x4 w; const f32x4 ga = *(const f32x4*)(cqn + ks * 32 + quad * 8), gb = *(const f32x4*)(cqn + ks * 32 + quad * 8 + 4);
#pragma unroll
        for (int e = 0; e < 4; ++e) { const float g0 = e < 2 ? ga[2 * e] : gb[2 * e - 4], g1 = e < 2 ? ga[2 * e + 1] : gb[2 * e - 3]; w[e] = cvt_pk_bf16(bf2f((bf16_t)aq[ks][2 * e]) * rq * g0, bf2f((bf16_t)aq[ks][2 * e + 1]) * rq * g1); }
        aq[ks] = __builtin_bit_cast(bf16x8, w); }
#pragma unroll
    for (int ks = 0; ks < 4; ++ks) { u32x4 w; const f32x4 ga = *(const f32x4*)(ckvn + ks * 32 + quad * 8), gb = *(const f32x4*)(ckvn + ks * 32 + quad * 8 + 4);
#pragma unroll
        for (int e = 0; e < 4; ++e) { const float g0 = e < 2 ? ga[2 * e] : gb[2 * e - 4], g1 = e < 2 ? ga[2 * e + 1] : gb[2 * e - 3]; w[e] = cvt_pk_bf16(bf2f((bf16_t)ak[ks][2 * e]) * rk * g0, bf2f((bf16_t)ak[ks][2 * e + 1]) * rk * g1); }
        ak[ks] = __builtin_bit_cast(bf16x8, w); }
    const float qs = 0.10206207261596577f * LOG2E;
    f32x4 cs4[2];
#pragma unroll
    for (int q = 0; q < 2; ++q) cs4[q] = *(const f32x4*)(rope + pos * 16 + quad * 4 + 2 * q);
#pragma unroll 1
    for (int hi_ = 0; hi_ < 2; ++hi_) { const int hh = 2 * hp + hi_;
        {   f32x4 acc[6];
#pragma unroll
            for (int nt = 0; nt < 6; ++nt) { acc[nt] = (f32x4){0.f, 0.f, 0.f, 0.f}; const bf16_t* wr_ = WuqT + (size_t)((hh * 6 + nt) * 16 + m) * 192 + quad * 8;
#pragma unroll
                for (int ks = 0; ks < 6; ++ks) acc[nt] = MFMA16(*(const bf16x8*)(wr_ + ks * 32), aq[ks], acc[nt]); }
#pragma unroll
            for (int j = 0; j < 4; ++j) { const float c = cs4[j >> 1][2 * (j & 1)], sn = cs4[j >> 1][2 * (j & 1) + 1]; const float x1 = acc[4][j], x2 = acc[5][j]; acc[4][j] = x1 * c - x2 * sn; acc[5][j] = x2 * c + x1 * sn; }
            bf16_t* qo = QC + (size_t)tok * 384 + hh * 96 + quad * 4;
#pragma unroll
            for (int nt = 0; nt < 6; ++nt) { u32x2 w; w.x = cvt_pk_bf16(acc[nt][0] * qs, acc[nt][1] * qs); w.y = cvt_pk_bf16(acc[nt][2] * qs, acc[nt][3] * qs); *(u32x2*)(qo + nt * 16) = w; } }
        {   f32x4 acc[8];
#pragma unroll
            for (int nt = 0; nt < 8; ++nt) { acc[nt] = (f32x4){0.f, 0.f, 0.f, 0.f}; const bf16_t* wr_ = WukvT + (size_t)((hh * 8 + nt) * 16 + m) * 128 + quad * 8;
#pragma unroll
                for (int ks = 0; ks < 4; ++ks) acc[nt] = MFMA16(*(const bf16x8*)(wr_ + ks * 32), ak[ks], acc[nt]); }
            bf16_t* ko = KC + (size_t)tok * 384 + hh * 96 + quad * 4; bf16_t* vo = VC + (size_t)tok * 256 + hh * 64 + quad * 4;
#pragma unroll
            for (int nt = 0; nt < 4; ++nt) { u32x2 w; w.x = cvt_pk_bf16(acc[nt][0], acc[nt][1]); w.y = cvt_pk_bf16(acc[nt][2], acc[nt][3]); *(u32x2*)(ko + nt * 16) = w;
                u32x2 w2; w2.x = cvt_pk_bf16(acc[nt + 4][0], acc[nt + 4][1]); w2.y = cvt_pk_bf16(acc[nt + 4][2], acc[nt + 4][3]); *(u32x2*)(vo + nt * 16) = w2; } }
    }
}
__device__ __forceinline__ void pp_mla_lds(int tok0, int hh, const bf16_t* PROJ, bf16_t* QC, bf16_t* KC, bf16_t* VC, const float2* rope, const char* Lq, const char* Lkv, const float* cqn, const float* ckvn, int lane) {
    const int m = lane & 15, quad = lane >> 4, tok = tok0 + m, pos = tok & (SEQ - 1);
    const bf16_t* crow_ = PROJ + (size_t)tok * PPITCH + PC;
    bf16x8 aq[6], ak[4]; float ssq_ = 0.f, ssk_ = 0.f;
#pragma unroll
    for (int ks = 0; ks < 6; ++ks) aq[ks] = *(const bf16x8*)(crow_ + ks * 32 + quad * 8);
#pragma unroll
    for (int ks = 0; ks < 4; ++ks) ak[ks] = *(const bf16x8*)(crow_ + 192 + ks * 32 + quad * 8);
#pragma unroll
    for (int ks = 0; ks < 6; ++ks)
#pragma unroll
        for (int e = 0; e < 8; ++e) { const float x = bf2f((bf16_t)aq[ks][e]); ssq_ += x * x; }
#pragma unroll
    for (int ks = 0; ks < 4; ++ks)
#pragma unroll
        for (int e = 0; e < 8; ++e) { const float x = bf2f((bf16_t)ak[ks][e]); ssk_ += x * x; }
    ssq_ += __shfl_xor(ssq_, 16); ssq_ += __shfl_xor(ssq_, 32); ssk_ += __shfl_xor(ssk_, 16); ssk_ += __shfl_xor(ssk_, 32);
    const float rq = 1.0f / sqrtf(ssq_ * (1.f / 192.f) + EPS), rk = 1.0f / sqrtf(ssk_ * (1.f / 128.f) + EPS);
#pragma unroll
    for (int ks = 0; ks < 6; ++ks) { u32x4 w; const f32x4 ga = *(const f32x4*)(cqn + ks * 32 + quad * 8), gb = *(const f32x4*)(cqn + ks * 32 + quad * 8 + 4);
#pragma unroll
        for (int e = 0; e < 4; ++e) { const float g0 = e < 2 ? ga[2 * e] : gb[2 * e - 4], g1 = e < 2 ? ga[2 * e + 1] : gb[2 * e - 3]; w[e] = cvt_pk_bf16(bf2f((bf16_t)aq[ks][2 * e]) * rq * g0, bf2f((bf16_t)aq[ks][2 * e + 1]) * rq * g1); }
        aq[ks] = __builtin_bit_cast(bf16x8, w); }
#pragma unroll
    for (int ks = 0; ks < 4; ++ks) { u32x4 w; const f32x4 ga = *(const f32x4*)(ckvn + ks * 32 + quad * 8), gb = *(const f32x4*)(ckvn + ks * 32 + quad * 8 + 4);
#pragma unroll
        for (int e = 0; e < 4; ++e) { const float g0 = e < 2 ? ga[2 * e] : gb[2 * e - 4], g1 = e < 2 ? ga[2 * e + 1] : gb[2 * e - 3]; w[e] = cvt_pk_bf16(bf2f((bf16_t)ak[ks][2 * e]) * rk * g0, bf2f((bf16_t)ak[ks][2 * e + 1]) * rk * g1); }
        ak[ks] = __builtin_bit_cast(bf16x8, w); }
    const float qs = 0.10206207261596577f * LOG2E;
    f32x4 cs4[2];
#pragma unroll
    for (int q = 0; q < 2; ++q) cs4[q] = *(const f32x4*)(rope + pos * 16 + quad * 4 + 2 * q);
    {
        {   f32x4 acc[6];
#pragma unroll
            for (int nt = 0; nt < 6; ++nt) { acc[nt] = (f32x4){0.f, 0.f, 0.f, 0.f}; const char* wr_ = Lq + (nt * 16 + m) * 400 + quad * 16;
#pragma unroll
                for (int ks = 0; ks < 6; ++ks) acc[nt] = MFMA16(*(const bf16x8*)(wr_ + ks * 64), aq[ks], acc[nt]); }
#pragma unroll
            for (int j = 0; j < 4; ++j) { const float c = cs4[j >> 1][2 * (j & 1)], sn = cs4[j >> 1][2 * (j & 1) + 1]; const float x1 = acc[4][j], x2 = acc[5][j]; acc[4][j] = x1 * c - x2 * sn; acc[5][j] = x2 * c + x1 * sn; }
            bf16_t* qo = QC + (size_t)tok * 384 + hh * 96 + quad * 4;
#pragma unroll
            for (int nt = 0; nt < 6; ++nt) { u32x2 w; w.x = cvt_pk_bf16(acc[nt][0] * qs, acc[nt][1] * qs); w.y = cvt_pk_bf16(acc[nt][2] * qs, acc[nt][3] * qs); *(u32x2*)(qo + nt * 16) = w; } }
        {   f32x4 acc[8];
#pragma unroll
            for (int nt = 0; nt < 8; ++nt) { acc[nt] = (f32x4){0.f, 0.f, 0.f, 0.f}; const char* wr_ = Lkv + (nt * 16 + m) * 288 + quad * 16;
#pragma unroll
                for (int ks = 0; ks < 4; ++ks) acc[nt] = MFMA16(*(const bf16x8*)(wr_ + ks * 64), ak[ks], acc[nt]); }
            bf16_t* ko = KC + (size_t)tok * 384 + hh * 96 + quad * 4; bf16_t* vo = VC + (size_t)tok * 256 + hh * 64 + quad * 4;
#pragma unroll
            for (int nt = 0; nt < 4; ++nt) { u32x2 w; w.x = cvt_pk_bf16(acc[nt][0], acc[nt][1]); w.y = cvt_pk_bf16(acc[nt][2], acc[nt][3]); *(u32x2*)(ko + nt * 16) = w;
                u32x2 w2; w2.x = cvt_pk_bf16(acc[nt + 4][0], acc[nt + 4][1]); w2.y = cvt_pk_bf16(acc[nt + 4][2], acc[nt + 4][3]); *(u32x2*)(vo + nt * 16) = w2; } }
    }
}

template <int DQK, int NSUB, int MODE>
__device__ __forceinline__ void flash_unit(LAS char* L, const bf16_t* Qp, int qpitch, const bf16_t* Kp, int kpitch, const bf16_t* Vp, int vpitch,
                                           bf16_t* Op, int opitch, float lam, float oscale, const float* subln) {
    constexpr int KW = NSUB * DQK, KPB = KW * 2 + 16, VPB = 144, KBUF = 64 * KPB, VBUF = 64 * VPB, KCH = KW / 8, NKCH = 64 * KCH, ND0 = DQK / 16;
    constexpr int OFF_V = 2 * KBUF;
    const int tid = otid(), lane = tid & 63, wid = tid >> 6, r32 = lane & 31, hi = lane >> 5;
    char* Lg = (char*)L;
    bf16x8 qf[NSUB][ND0];
    { const bf16_t* qrow = Qp + (size_t)(32 * wid + r32) * qpitch;
#pragma unroll
      for (int s = 0; s < NSUB; ++s)
#pragma unroll
          for (int d0 = 0; d0 < ND0; ++d0) qf[s][d0] = *(const bf16x8*)(qrow + s * DQK + 16 * d0 + 8 * hi); }
    const int kr1 = tid / KCH, kc1 = tid % KCH, kr2 = (tid + 512) / KCH, kc2 = (tid + 512) % KCH; const bool has2 = (tid + 512) < NKCH;
    const int vr1 = tid >> 3, vc1 = tid & 7;
    const bf16_t* kg1 = Kp + (size_t)kr1 * kpitch + kc1 * 8; const bf16_t* kg2 = Kp + (size_t)kr2 * kpitch + kc2 * 8; const bf16_t* vg1 = Vp + (size_t)vr1 * vpitch + vc1 * 8;
    const int kl1 = kr1 * KPB + kc1 * 16, kl2 = kr2 * KPB + kc2 * 16, vl1 = vr1 * VPB + vc1 * 16;
    u32x4 rk1, rk2 = {0u, 0u, 0u, 0u}, rv1;
    float mref[NSUB], lrow[NSUB]; f32x16 o[NSUB][2], negm[NSUB];
#pragma unroll
    for (int s = 0; s < NSUB; ++s) { mref[s] = 0.f; lrow[s] = 0.f;
#pragma unroll
        for (int r = 0; r < 16; ++r) { o[s][0][r] = 0.f; o[s][1][r] = 0.f; negm[s][r] = 0.f; } }
    __syncthreads();
    rk1 = *(const u32x4*)kg1; if (has2) rk2 = *(const u32x4*)kg2; rv1 = *(const u32x4*)vg1;
    *(u32x4*)(Lg + kl1) = rk1; if (has2) *(u32x4*)(Lg + kl2) = rk2; *(u32x4*)(Lg + OFF_V + vl1) = rv1;
    __syncthreads();
    const int vq = (lane & 15) >> 2, vp_ = lane & 3, vblk = (lane >> 4) & 1;
    const int voff = (4 * hi + vq) * VPB + (16 * vblk + 4 * vp_) * 2;
    if (__builtin_amdgcn_readfirstlane(wid) >= 4) __builtin_amdgcn_s_setprio(1);
    for (int t = 0; t < SEQ / 64; ++t) {
        const int buf = t & 1;
        if (t + 1 < SEQ / 64) { const size_t ko = (size_t)(t + 1) * 64 * kpitch, vo = (size_t)(t + 1) * 64 * vpitch;
            rk1 = *(const u32x4*)(kg1 + ko); if (has2) rk2 = *(const u32x4*)(kg2 + ko); rv1 = *(const u32x4*)(vg1 + vo); }
        const char* Kb = Lg + buf * KBUF; LAS const char* Vb = L + OFF_V + buf * VBUF + voff;
#pragma unroll
        for (int s = 0; s < NSUB; ++s) {
            f32x16 p0, p1;
#pragma unroll
            for (int d0 = 0; d0 < ND0; ++d0) { const bf16x8 k0 = *(const bf16x8*)(Kb + r32 * KPB + (s * DQK + 16 * d0 + 8 * hi) * 2); const bf16x8 k1 = *(const bf16x8*)(Kb + (32 + r32) * KPB + (s * DQK + 16 * d0 + 8 * hi) * 2);
                if (d0 == 0) { p0 = MFMA32(k0, qf[s][d0], negm[s]); p1 = MFMA32(k1, qf[s][d0], negm[s]); }
                else { p0 = MFMA32(k0, qf[s][d0], p0); p1 = MFMA32(k1, qf[s][d0], p1); } }
#pragma unroll
            for (int hf = 0; hf < 2; ++hf) {
                f32x16& ph = hf ? p1 : p0;
                float mx = fmaxf(ph[0], ph[1]);
#pragma unroll
                for (int r = 2; r < 16; ++r) mx = fmaxf(mx, ph[r]);
                mx = fmaxf(mx, __shfl_xor(mx, 32));
                const bool first = (t == 0) && (hf == 0);
                if (first || __any(mx > 8.0f)) {
                    const float dl = first ? mx : fmaxf(mx, 0.f); mref[s] += dl;
#pragma unroll
                    for (int r = 0; r < 16; ++r) { ph[r] -= dl; negm[s][r] = -mref[s]; }
                    if (hf == 0) {
#pragma unroll
                        for (int r = 0; r < 16; ++r) p1[r] -= dl;
                    }
                    if (!first) { const float alpha = __builtin_amdgcn_exp2f(-dl); lrow[s] *= alpha;
#pragma unroll
                        for (int r = 0; r < 16; ++r) { o[s][0][r] *= alpha; o[s][1][r] *= alpha; } }
                }
#pragma unroll
                for (int r = 0; r < 16; ++r) ph[r] = __builtin_amdgcn_exp2f(ph[r]);
                { typedef float f32x2_ __attribute__((ext_vector_type(2))); f32x2_ r2 = {ph[0], ph[1]};
#pragma unroll
                  for (int r = 2; r < 16; r += 2) r2 += (f32x2_){ph[r], ph[r + 1]};
                  lrow[s] += r2[0] + r2[1]; }
                bf16x8 pf[2];
#pragma unroll
                for (int k2 = 0; k2 < 2; ++k2) { u32x4 w;
#pragma unroll
                    for (int e = 0; e < 4; ++e) w[e] = cvt_pk_bf16(ph[8 * k2 + 2 * e], ph[8 * k2 + 2 * e + 1]);
                    pf[k2] = __builtin_bit_cast(bf16x8, w); }
#pragma unroll
                for (int db = 0; db < 2; ++db)
#pragma unroll
                    for (int k2 = 0; k2 < 2; ++k2) { const int ks = 2 * hf + k2; const v4i16_t lo = vtr(Vb + (16 * ks) * VPB + db * 64), hh = vtr(Vb + (16 * ks + 8) * VPB + db * 64);
                        const bf16x8 vf = {lo[0], lo[1], lo[2], lo[3], hh[0], hh[1], hh[2], hh[3]};
                        o[s][db] = MFMA32(vf, pf[k2], o[s][db]); }
            }
        }
        if (t + 1 < SEQ / 64) { char* Kn = Lg + (buf ^ 1) * KBUF; *(u32x4*)(Kn + kl1) = rk1; if (has2) *(u32x4*)(Kn + kl2) = rk2; *(u32x4*)(Lg + OFF_V + (buf ^ 1) * VBUF + vl1) = rv1; }
        __syncthreads();
    }
    __builtin_amdgcn_s_setprio(0);
    bf16_t* orow = Op + (size_t)(32 * wid + r32) * opitch;
    if (MODE == 0) {
        const float inv = 1.0f / (lrow[0] + __shfl_xor(lrow[0], 32));
#pragma unroll
        for (int db = 0; db < 2; ++db)
#pragma unroll
            for (int g = 0; g < 4; ++g) { u32x2 w; w.x = cvt_pk_bf16(o[0][db][4 * g] * inv, o[0][db][4 * g + 1] * inv); w.y = cvt_pk_bf16(o[0][db][4 * g + 2] * inv, o[0][db][4 * g + 3] * inv);
                *(u32x2*)(orow + 32 * db + 8 * g + 4 * hi) = w; }
    } else {
        const float i1 = 1.0f / (lrow[0] + __shfl_xor(lrow[0], 32)), i2 = lam / (lrow[NSUB - 1] + __shfl_xor(lrow[NSUB - 1], 32));
        float ss = 0.f;
#pragma unroll
        for (int db = 0; db < 2; ++db)
#pragma unroll
            for (int r = 0; r < 16; ++r) { const float v = o[0][db][r] * i1 - o[NSUB - 1][db][r] * i2; o[0][db][r] = v; ss += v * v; }
        ss += __shfl_xor(ss, 32);
        const float rn = oscale / sqrtf(ss * (1.f / 64.f) + EPS);
#pragma unroll
        for (int db = 0; db < 2; ++db)
#pragma unroll
            for (int g = 0; g < 4; ++g) { const int d = 32 * db + 8 * g + 4 * hi; const f32x4 sg = *(const f32x4*)(subln + d);
                u32x2 w; w.x = cvt_pk_bf16(o[0][db][4 * g] * rn * sg[0], o[0][db][4 * g + 1] * rn * sg[1]); w.y = cvt_pk_bf16(o[0][db][4 * g + 2] * rn * sg[2], o[0][db][4 * g + 3] * rn * sg[3]);
                *(u32x2*)(orow + d) = w; }
    }
}

__device__ __forceinline__ void natten_unit(LAS char* L, const bf16_t* Pseq  , bf16_t* Oseq  , int h, int r0, const float* rpb) {
    constexpr int VPB = 144, OFF_RPB = 11 * 64 * VPB;
    const int tid = otid(), lane = tid & 63, wid = tid >> 6, m = lane & 15, quad = lane >> 4;
    char* Lg = (char*)L; float* rpbL = (float*)(Lg + OFF_RPB);
    int rs_lo = r0 - 4; rs_lo = rs_lo < 0 ? 0 : (rs_lo > 24 ? 24 : rs_lo);
    int rs_hi = r0 + 3 - 4; rs_hi = rs_hi < 0 ? 0 : (rs_hi > 24 ? 24 : rs_hi);
    const int nst = (rs_hi - rs_lo + 8) * 64 * 8;
    __syncthreads();
    {   const bf16_t* vsrc = Pseq + (size_t)(rs_lo * 64) * PPITCH + PB + 512 + h * 64;
#pragma unroll
        for (int i = 0; i < 11; ++i) { const int c = tid + 512 * i; if (c < nst) { const int row = c >> 3, ch = c & 7; *(u32x4*)(Lg + row * VPB + ch * 16) = *(const u32x4*)(vsrc + (size_t)row * PPITCH + ch * 8); } }
        if (tid < 465) rpbL[tid] = rpb[h * 465 + tid] * LOG2E;
    }
    __syncthreads();
#pragma unroll 1
    for (int it = 0; it < 2; ++it) {
        const int item = wid + 8 * it, r = r0 + (item >> 2), n = item & 3;
        int rs = r - 4; rs = rs < 0 ? 0 : (rs > 24 ? 24 : rs);
        int cb = 16 * n - 8; cb = cb < 0 ? 0 : (cb > 32 ? 32 : cb);
        const int qcol = 16 * n + m; int cs = qcol - 8; cs = cs < 0 ? 0 : (cs > 48 ? 48 : cs);
        const bf16_t* qrow = Pseq + (size_t)(r * 64 + qcol) * PPITCH + PB + h * 64 + quad * 8;
        const bf16x8 qf0 = *(const bf16x8*)qrow, qf1 = *(const bf16x8*)(qrow + 32);
        f32x4 sc[16];
#pragma unroll
        for (int t = 0; t < 16; ++t) { const int kr = t >> 1, kc0 = (t & 1) * 16;
            const bf16_t* krow = Pseq + (size_t)((rs + kr) * 64 + cb + kc0 + m) * PPITCH + PB + 256 + h * 64 + quad * 8;
            const bf16x8 k0 = *(const bf16x8*)krow, k1 = *(const bf16x8*)(krow + 32);
            f32x4 a = {0.f, 0.f, 0.f, 0.f}; a = MFMA16(k0, qf0, a); a = MFMA16(k1, qf1, a);
            const int dr = rs + kr - r + 7;
#pragma unroll
            for (int j = 0; j < 4; ++j) { const int kcol = cb + kc0 + 4 * quad + j; const bool ok = (kcol >= cs) && (kcol < cs + 16); int dc = kcol - qcol + 15; dc = dc < 0 ? 0 : (dc > 30 ? 30 : dc);
                a[j] = ok ? a[j] + rpbL[dr * 31 + dc] : -INFINITY; }
            sc[t] = a; }
        float mx = -INFINITY;
#pragma unroll
        for (int t = 0; t < 16; ++t) mx = fmaxf(mx, fmaxf(fmaxf(sc[t][0], sc[t][1]), fmaxf(sc[t][2], sc[t][3])));
        mx = fmaxf(mx, __shfl_xor(mx, 16)); mx = fmaxf(mx, __shfl_xor(mx, 32));
        float sum = 0.f;
#pragma unroll
        for (int t = 0; t < 16; ++t)
#pragma unroll
            for (int j = 0; j < 4; ++j) { const float e = __builtin_amdgcn_exp2f(sc[t][j] - mx); sc[t][j] = e; sum += e; }
        sum += __shfl_xor(sum, 16); sum += __shfl_xor(sum, 32);
        const float inv = 1.0f / sum;
        f32x4 o[4];
#pragma unroll
        for (int dt = 0; dt < 4; ++dt) o[dt] = (f32x4){0.f, 0.f, 0.f, 0.f};
        LAS const char* Vb = L + (size_t)((rs - rs_lo) * 64 + cb + 4 * quad + (m >> 2)) * VPB + (lane & 3) * 8;
#pragma unroll
        for (int u = 0; u < 8; ++u) { u32x4 w; w.x = cvt_pk_bf16(sc[2 * u][0], sc[2 * u][1]); w.y = cvt_pk_bf16(sc[2 * u][2], sc[2 * u][3]);
            w.z = cvt_pk_bf16(sc[2 * u + 1][0], sc[2 * u + 1][1]); w.w = cvt_pk_bf16(sc[2 * u + 1][2], sc[2 * u + 1][3]);
            const bf16x8 pf = __builtin_bit_cast(bf16x8, w);
#pragma unroll
            for (int dt = 0; dt < 4; ++dt) { const v4i16_t lo = vtr(Vb + (u * 64) * VPB + dt * 32), hh = vtr(Vb + (u * 64 + 16) * VPB + dt * 32);
                const bf16x8 vf = {lo[0], lo[1], lo[2], lo[3], hh[0], hh[1], hh[2], hh[3]};
                o[dt] = MFMA16(vf, pf, o[dt]); } }
        bf16_t* orow = Oseq + (size_t)(r * 64 + qcol) * 256 + h * 64 + 4 * quad;
#pragma unroll
        for (int dt = 0; dt < 4; ++dt) { u32x2 w; w.x = cvt_pk_bf16(o[dt][0] * inv, o[dt][1] * inv); w.y = cvt_pk_bf16(o[dt][2] * inv, o[dt][3] * inv); *(u32x2*)(orow + dt * 16) = w; }
    }
}

#define XB_TMO      128
#define XB_XCNT(j)  (256  + 64 * (j))
#define XB_XSUB(j)  (1280 + 64 * (j))
#define XB_XGEN(j)  (2304 + 64 * (j))
#define XB_TOP      3328
#define XB_TOPGEN   3392
#define XCD_BAR_WORDS 3456
#define XB_SPIN_CAP (1u << 18)

__device__ __forceinline__ unsigned xb_ld(unsigned* p)              { return __hip_atomic_load(p, __ATOMIC_RELAXED, __HIP_MEMORY_SCOPE_AGENT); }
__device__ __forceinline__ unsigned xb_add(unsigned* p, unsigned v) { return __hip_atomic_fetch_add(p, v, __ATOMIC_RELAXED, __HIP_MEMORY_SCOPE_AGENT); }
__device__ __forceinline__ unsigned xb_xcc_id() { return (unsigned)__builtin_amdgcn_s_getreg((3 << 11) | 20) & 0xFu; }
#define XB_SPIN(cond, bar) do { unsigned _sp = 0; while (cond) { __builtin_amdgcn_s_sleep(1); \
    if ((++_sp & 255u) == 0u) { if (xb_ld(&(bar)[XB_TMO])) break; if (_sp > XB_SPIN_CAP) { atomicAdd(&(bar)[XB_TMO], 1u); break; } } } } while (0)

struct XcdBarrier {
    unsigned* bar; unsigned x;
    volatile LAS unsigned* st;
};

__device__ __forceinline__ XcdBarrier xcd_barrier_post(unsigned* bar, volatile LAS unsigned* st) {
    XcdBarrier b; b.bar = bar; b.x = xb_xcc_id(); b.st = st;
    if (threadIdx.x == 0) (void)xb_add(&bar[XB_XCNT(b.x)], 1u);
    return b;
}
__device__ __forceinline__ void xcd_barrier_complete(unsigned* bar, unsigned x, unsigned& nloc, unsigned& nx) {
    const unsigned G = gridDim.x * gridDim.y * gridDim.z;
    unsigned sum, cnt, mine, sp = 0u;
    for (;;) {
        sum = 0u; cnt = 0u; mine = 0u;
#pragma unroll
        for (unsigned j = 0; j < 16; ++j) { const unsigned c = xb_ld(&bar[XB_XCNT(j)]); sum += c; cnt += (c > 0u) ? 1u : 0u; mine = (j == x) ? c : mine; }
        if (sum == G) break;
        __builtin_amdgcn_s_sleep(1);
        if ((++sp & 255u) == 0u) { if (xb_ld(&bar[XB_TMO])) break; if (sp > XB_SPIN_CAP) { atomicAdd(&bar[XB_TMO], 1u); break; } }
    }
    nloc = mine > 0u ? mine : 1u; nx = cnt > 0u ? cnt : 1u;
}

__device__ __forceinline__ void xcd_barrier(const XcdBarrier& b) {
    asm volatile("s_waitcnt vmcnt(0)" ::: "memory");
    __syncthreads();
    if (threadIdx.x == 0) {
        unsigned* bar = b.bar;
        __builtin_amdgcn_s_waitcnt(0);
        unsigned nloc = b.st[0], nx = b.st[1];
        if (nloc == 0u) { xcd_barrier_complete(bar, b.x, nloc, nx); b.st[0] = nloc; b.st[1] = nx; }
        const unsigned old = xb_add(&bar[XB_XSUB(b.x)], 1u);
        const unsigned gen = old / nloc;
        if (old + 1u == (gen + 1u) * nloc) {
            __builtin_amdgcn_fence(__ATOMIC_RELEASE, "agent");
            asm volatile("s_waitcnt vmcnt(0)" ::: "memory");
            const unsigned og = xb_add(&bar[XB_TOP], 1u);
            const unsigned tg = og / nx;
            if (og + 1u == (tg + 1u) * nx) xb_add(&bar[XB_TOPGEN], 1u);
            else XB_SPIN(xb_ld(&bar[XB_TOPGEN]) == tg, bar);
            __builtin_amdgcn_fence(__ATOMIC_ACQUIRE, "agent");
            xb_add(&bar[XB_XGEN(b.x)], 1u);
            asm volatile("s_waitcnt vmcnt(0)" ::: "memory");
        } else {
            XB_SPIN(xb_ld(&bar[XB_XGEN(b.x)]) == gen, bar);
            __builtin_amdgcn_fence(__ATOMIC_ACQUIRE, "agent");
            asm volatile("s_waitcnt vmcnt(0)" ::: "memory");
        }
    }
    __syncthreads();
}

__global__ void __launch_bounds__(NTHR, 2) mega_fwd(Args a) {
    extern __shared__ __attribute__((aligned(16))) unsigned char lds_raw[];
    cg::grid_group grid = cg::this_grid();
    LAS unsigned char* lds = (LAS unsigned char*)lds_raw;
    const int G = gridDim.x, bx = blockIdx.x;
    const int vcu = (G % 8 == 0) ? (bx % 8) * (G / 8) + bx / 8 : bx;
    const int NGW = G * NWAVES, NT = G * NTHR;
#define TIDS() const int tid = otid(), lane = tid & 63, wave = __builtin_amdgcn_readfirstlane(tid >> 6), gw = vcu * NWAVES + wave, gtid = vcu * NTHR + tid; (void)lane; (void)gw; (void)gtid
#define WSP(name) unsigned char* name = a.ws; asm volatile("" : "+s"(name))

    volatile LAS unsigned* MISC = (volatile LAS unsigned*)(lds + 133120);
    if (otid() < 32) MISC[otid()] = 0u;
    __syncthreads();
    XcdBarrier bar = xcd_barrier_post((unsigned*)a.ws, MISC + 8);
#define GSYNC() xcd_barrier(bar)
    PH(0) { WSP(w); TIDS(); prologue(a, w, (char*)lds_raw, gw, NGW, wave, lane); }
    grid.sync();

#pragma unroll 1
    for (int g = 0; g < NGROUP; ++g) {
#pragma unroll 1
        for (int l = 0; l < DEPTH; ++l) {
            int row_g0 = g * TMAX, T = (g < 2) ? TMAX : (NTOK - 2 * TMAX); asm volatile("" : "+s"(row_g0), "+s"(T));
            if (l == 0) {
                PH(1) { WSP(w); TIDS(); convert_phase(a.in[0], a.in[1], row_g0, T, (bf16_t*)(w + WS_XN), (float*)(w + WS_MRG), gw, NGW, lane); }
                GSYNC();
            }
            PH(2) { WSP(w); pg8::Gemm gm{(const bf16_t*)(w + WS_XN), (const bf16_t*)(w + WS_WIN) + (size_t)l * NPROJ * DM, T, NPROJ, DM}; pg8::StaticOrder S; S.init(T, NPROJ, G, bx); pg8::EpiProj E{(bf16_t*)(w + WS_PROJ), PPITCH, PG / 256, (const float*)(w + WS_MRG), (bf16_t*)(w + WS_RAT), T};
              pg8::gemm_phase<pg8::EpiProj, pg8::StaticOrder, true, true>(lds, gm, S, E); }
            GSYNC();
            PH(3) { WSP(w); TIDS(); bf16_t* PROJ = (bf16_t*)(w + WS_PROJ);
                bf16_t* KC = (bf16_t*)(w + WS_KC); const float2* rope = (const float2*)(w + WS_ROPE);
#pragma unroll 1
                for (int t0 = gw; t0 < T; t0 += 2 * NGW) { if (t0 + NGW < T) { const int tk[2] = {t0, t0 + NGW}; pp_elem<2>(tk, PROJ, KC, rope, a.in[14] + l * 64, a.in[15] + l * 64, lane); }
                                                          else { const int tk[1] = {t0}; pp_elem<1>(tk, PROJ, KC, rope, a.in[14] + l * 64, a.in[15] + l * 64, lane); } }
                }
#pragma unroll 1
                for (int hh = 0; hh < 4; ++hh) { WSP(w2); TIDS(); char* Lw = (char*)lds_raw;
                    const bf16_t* Wq_ = (const bf16_t*)(w2 + WS_WUQ) + (size_t)l * 384 * 192 + (size_t)hh * 96 * 192; const bf16_t* Wkv_ = (const bf16_t*)(w2 + WS_WUKV) + (size_t)l * 512 * 128 + (size_t)hh * 128 * 128;
                    __syncthreads();
#pragma unroll
                    for (int i_ = 0; i_ < 9; ++i_) { const int c = tid + 512 * i_;
                        if (c < 2304) { const int row = c / 24, ch = c - row * 24; *(u32x4*)(Lw + row * 400 + ch * 16) = *(const u32x4*)(Wq_ + row * 192 + ch * 8); }
                        else if (c < 4352) { const int c2 = c - 2304, row = c2 >> 4, ch = c2 & 15; *(u32x4*)(Lw + 38400 + row * 288 + ch * 16) = *(const u32x4*)(Wkv_ + row * 128 + ch * 8); } }
                    __syncthreads();
#pragma unroll 1
                    for (int tl = gw; tl < T / 16; tl += NGW) pp_mla_lds(tl * 16, hh, (const bf16_t*)(w2 + WS_PROJ), (bf16_t*)(w2 + WS_QC), (bf16_t*)(w2 + WS_KC), (bf16_t*)(w2 + WS_VC), (const float2*)(w2 + WS_ROPE), Lw, Lw + 38400, a.in[10] + l * 192, a.in[11] + l * 128, lane);
                }
            GSYNC();
            PH(4) {
                const float lam_init = (l == 0) ? 0.2f : (0.8f - 0.6f * 0.7408182206817179f);
                const int NU_F = (T >> 11) * 4 * 8, NU_B = (T >> 11) * 4 * 8;
                if (FLK & 1) {
                    float s1 = 0.f, s2 = 0.f;
                    for (int i = 0; i < 32; ++i) { s1 += a.in[4][l * 32 + i] * a.in[5][l * 32 + i]; s2 += a.in[6][l * 32 + i] * a.in[7][l * 32 + i]; }
                    const float lam = expf(s1) - expf(s2) + lam_init;
#pragma unroll 1
                    for (int uu = vcu; uu < NU_F; uu += G) { WSP(w); bf16_t* PROJ = (bf16_t*)(w + WS_PROJ); bf16_t* OB = (bf16_t*)(w + WS_OB);
                        const int b = uu >> 5, h = (uu >> 3) & 3, qb = uu & 7; const size_t sb = (size_t)b * SEQ, q0 = sb + (size_t)qb * 256;
                        flash_unit<32, 2, 1>((LAS char*)lds, PROJ + q0 * PPITCH + PA + h * 64, PPITCH, PROJ + sb * PPITCH + PA + 256 + h * 64, PPITCH, PROJ + sb * PPITCH + PA + 512 + h * 64, PPITCH,
                                             OB + q0 * 256 + h * 64, 256, lam, 1.0f - lam_init, a.in[8] + l * 64); } }
                if (FLK & 2) {
#pragma unroll 1
                    for (int uu = vcu; uu < NU_F; uu += G) { WSP(w); bf16_t* QC = (bf16_t*)(w + WS_QC); bf16_t* KC = (bf16_t*)(w + WS_KC); bf16_t* VC = (bf16_t*)(w + WS_VC); bf16_t* OB = (bf16_t*)(w + WS_OB);
                        const int b = uu >> 5, h = (uu >> 3) & 3, qb = uu & 7; const size_t sb = (size_t)b * SEQ, q0 = sb + (size_t)qb * 256;
                        flash_unit<96, 1, 0>((LAS char*)lds, QC + q0 * 384 + h * 96, 384, KC + sb * 384 + h * 96, 384, VC + sb * 256 + h * 64, 256,
                                             OB + (size_t)2 * T * 256 + q0 * 256 + h * 64, 256, 0.f, 1.f, nullptr); } }
                if (FLK & 4) {
#pragma unroll 1
                    for (int uu = vcu; uu < NU_F; uu += G) { WSP(w); bf16_t* PROJ = (bf16_t*)(w + WS_PROJ); bf16_t* OB = (bf16_t*)(w + WS_OB);
                        const int b = uu >> 5, h = (uu >> 3) & 3, qb = uu & 7; const size_t sb = (size_t)b * SEQ, q0 = sb + (size_t)qb * 256;
                        flash_unit<64, 1, 0>((LAS char*)lds, PROJ + q0 * PPITCH + PD + h * 64, PPITCH, PROJ + sb * PPITCH + PD + 256 + (h >> 1) * 64, PPITCH, PROJ + sb * PPITCH + PD + 384 + (h >> 1) * 64, PPITCH,
                                             OB + (size_t)3 * T * 256 + q0 * 256 + h * 64, 256, 0.f, 1.f, nullptr); } }
                if (FLK & 8) {
#pragma unroll 1
                    for (int uu = vcu; uu < NU_B; uu += G) { WSP(w); bf16_t* PROJ = (bf16_t*)(w + WS_PROJ); bf16_t* OB = (bf16_t*)(w + WS_OB);
                        const int b = uu >> 5, h = (uu >> 3) & 3, r0 = (uu & 7) * 4;
                        natten_unit((LAS char*)lds, PROJ + (size_t)b * SEQ * PPITCH, OB + (size_t)1 * T * 256 + (size_t)b * SEQ * 256, h, r0, a.in[9] + l * 4 * 465); } }
            }
            GSYNC();
            PH(5) { WSP(w); pg8::Gemm gm{(const bf16_t*)(w + WS_OB), (const bf16_t*)(w + WS_WBR) + (size_t)l * 4 * 1024 * 256, 4 * T, 4096, 256}; pg8::BranchOrder S{T / 256, G, bx};
              pg8::EpiBranch E{(const bf16_t*)(w + WS_RAT), T, (bf16_t*)(w + WS_MB), T / 256};
              pg8::gemm_phase<pg8::EpiBranch, pg8::BranchOrder, true, true>(lds, gm, S, E); }
            GSYNC();
            PH(6) { WSP(w); pg8::Gemm gm{(const bf16_t*)(w + WS_MB), (const bf16_t*)(w + WS_WOUT) + (size_t)l * DM * DM, T, DM, DM}; asm volatile("" : "+s"(gm.A), "+s"(gm.Bt)); pg8::StaticOrder S; S.init(T, DM, G, bx);
              pg8::EpiResid E{(bf16_t*)(w + WS_XN), (float*)(w + WS_MRG) + 16 * TMAX};
              pg8::gemm_phase<pg8::EpiResid, pg8::StaticOrder, true, true>(lds, gm, S, E); }
            GSYNC();
            PH(8) { WSP(w); pg8::Gemm gm{(const bf16_t*)(w + WS_XN), (const bf16_t*)(w + WS_WFI) + (size_t)l * NUG * DM, T, NUG, DM}; asm volatile("" : "+s"(gm.A), "+s"(gm.Bt)); pg8::StaticOrder S; S.init(T, NUG, G, bx);
              pg8::EpiFfn E{(bf16_t*)(w + WS_ACT), (float*)(w + WS_MRG) + 64 * TMAX, (const float*)(w + WS_MRG) + 16 * TMAX, a.in[20] + (size_t)l * 3 * FF, a.in[21] + (size_t)l * FF, T / 64};
              pg8::gemm_phase<pg8::EpiFfn, pg8::StaticOrder, true, true>(lds, gm, S, E); }
            GSYNC();
            PH(9) { WSP(w); TIDS(); conv_fix_phase((const float*)(w + WS_MRG) + 64 * TMAX, (bf16_t*)(w + WS_ACT), a.in[20] + (size_t)l * 3 * FF, T, gtid, NT); }
            GSYNC();
            PH(10) { WSP(w); pg8::Gemm gm{(const bf16_t*)(w + WS_ACT), (const bf16_t*)(w + WS_WFO) + (size_t)l * DM * FF, T, DM, FF}; asm volatile("" : "+s"(gm.A), "+s"(gm.Bt)); pg8::StaticOrder S; S.init(T, DM, G, bx);
              pg8::EpiResid E{(bf16_t*)(w + WS_XN), (float*)(w + WS_MRG)};
              pg8::gemm_phase<pg8::EpiResid, pg8::StaticOrder, true, true>(lds, gm, S, E); }
            GSYNC();
            PH(11) { WSP(w); TIDS(); if (l == DEPTH - 1) final_norm_phase(a.out, row_g0, T, (const bf16_t*)(w + WS_XN), (const float*)(w + WS_MRG), a.in[23], gw, NGW, lane); }
            if (l == DEPTH - 1) GSYNC();
        }
    }
}

extern "C" void kernel_launch(void* const* d_in, const int* in_sizes, int n_in, void* d_out, int out_size, void* d_ws, size_t ws_size, hipStream_t stream) {
    static int grid = 0;
    if (grid == 0) {
        if (n_in != 24 || out_size != NTOK * DM || ws_size < WS_END) { fprintf(stderr, "kernel_launch: unexpected shapes (n_in %d, out %d, ws %zu)\n", n_in, out_size, ws_size); grid = -1; return; }
        int dev = 0, cus = 0, per_cu = 0;
        if (hipGetDevice(&dev) != hipSuccess || hipDeviceGetAttribute(&cus, hipDeviceAttributeMultiprocessorCount, dev) != hipSuccess) { grid = -1; return; }
        if (hipFuncSetAttribute((const void*)mega_fwd, hipFuncAttributeMaxDynamicSharedMemorySize, LDS_BYTES) != hipSuccess) { fprintf(stderr, "kernel_launch: hipFuncSetAttribute failed\n"); grid = -1; return; }
        if (hipOccupancyMaxActiveBlocksPerMultiprocessor(&per_cu, (const void*)mega_fwd, NTHR, LDS_BYTES) != hipSuccess || per_cu < 1) { fprintf(stderr, "kernel_launch: occupancy query says %d\n", per_cu); per_cu = 1; }
        (void)hipGetLastError();
        grid = cus * per_cu;
    }
    if (grid < 0) return;
    if (hipMemsetAsync(d_ws, 0, 16384, stream) != hipSuccess) { fprintf(stderr, "kernel_launch: memset of barrier words failed\n"); return; }
    Args a{};
    for (int i = 0; i < 24; ++i) a.in[i] = (const float*)d_in[i];
    a.out = (float*)d_out; a.ws = (unsigned char*)d_ws;
    void* args[] = {&a};
    hipError_t e = hipLaunchCooperativeKernel((const void*)mega_fwd, dim3(grid), dim3(NTHR), args, LDS_BYTES, stream);
    if (e != hipSuccess) fprintf(stderr, "kernel_launch: cooperative launch failed: %s (grid %d)\n", hipGetErrorString(e), grid);
}
```

```cpp
#include <hip/hip_runtime.h>
#include <hip/hip_cooperative_groups.h>
#include <cstdio>
#include <cstdint>
namespace cg = cooperative_groups;

__device__ __forceinline__ int otid() { int t = threadIdx.x; asm volatile("" : "+v"(t)); return t; }
namespace pg8 {
#define PG8_LAS __attribute__((address_space(3)))
typedef unsigned short bf16_t;
typedef short bf16x8 __attribute__((ext_vector_type(8)));
typedef float f32x4 __attribute__((ext_vector_type(4)));
typedef unsigned u32x4 __attribute__((ext_vector_type(4)));
constexpr int BM = 256, BK = 64, HALF = 128, HTB = HALF * BK * 2  , STAGE_BYTES = 8 * HTB, NXCD = 8, WGM = 8;

__host__ __device__ __forceinline__ int lds_byte(int r, int c) { const int st = (r >> 4) * 2 + (c >> 5), rr = r & 15, cc = c & 31, ob = rr * 64 + cc * 2; return st * 1024 + (ob ^ (((ob >> 9) & 1) << 5)); }
__host__ __device__ __forceinline__ void stage_rc(int b, int& R, int& C) { const int st = b / 1024, sb = b % 1024, swz = sb ^ (((sb >> 9) & 1) << 5); R = (st >> 1) * 16 + swz / 64; C = (st & 1) * 32 + (swz % 64) / 2; }
__host__ __device__ __forceinline__ int perm32(int rho) { const int n = rho >> 4, i = rho & 15; return 8 * (i >> 2) + 4 * n + (i & 3); }

struct Unit { int pm, pn; };
struct Gemm { const bf16_t* A; const bf16_t* Bt; int M, N, K; };

struct StaticOrder {
    int nM, nN, nwg, G, c;
    __host__ __device__ void init(int M, int N, int G_, int c_) { nM = M / BM; nN = N / BM; nwg = nM * nN; G = G_; c = c_; }
    __host__ __device__ bool next(int i, Unit& u) const {
        const long L = (long)i * G + c; if (L >= nwg) return false;
        int wgid = (int)L; { const int q = nwg / NXCD, r = nwg % NXCD, xcd = wgid % NXCD, off = wgid / NXCD; wgid = (xcd < r ? xcd * (q + 1) : r * (q + 1) + (xcd - r) * q) + off; }
        const int nig = WGM * nN, gid = wgid / nig, fm = gid * WGM, gsz = (nM - fm) < WGM ? (nM - fm) : WGM;
        u.pm = fm + ((wgid % nig) % gsz); u.pn = (wgid % nig) / gsz; return true;
    }
    __device__ __forceinline__ void a_ready(const Unit&) const {}
    __device__ __forceinline__ void done(const Unit&) const {}
};


__device__ __forceinline__ unsigned cvt_pk_bf16(float lo, float hi) { typedef float f2 __attribute__((ext_vector_type(2))); typedef __bf16 b2 __attribute__((ext_vector_type(2))); f2 v = {lo, hi}; b2 b = __builtin_convertvector(v, b2); return __builtin_bit_cast(unsigned, b); }
__device__ __forceinline__ float sigm(float v) { return __builtin_amdgcn_rcpf(1.0f + __builtin_amdgcn_exp2f(-1.4426950408889634f * v)); }
__device__ __forceinline__ void rows_rstd8(const float* ssq, int row0, int fq, float (&rs)[2][4]) {
    f32x4 p[2][4];
#pragma unroll
    for (int ai = 0; ai < 2; ++ai)
#pragma unroll
        for (int m = 0; m < 4; ++m) p[ai][m] = ((const f32x4*)(ssq + (size_t)(row0 + ai * HALF + m * 16) * 16))[fq];
#pragma unroll
    for (int ai = 0; ai < 2; ++ai)
#pragma unroll
        for (int m = 0; m < 4; ++m) { float v = (p[ai][m][0] + p[ai][m][1]) + (p[ai][m][2] + p[ai][m][3]); v += __shfl_xor(v, 16); v += __shfl_xor(v, 32); rs[ai][m] = __builtin_amdgcn_rsqf(v * (1.0f / 1024.0f) + 1e-6f); }
}
struct EpiProj {
    static constexpr bool PERM = true, AFTER_DRAIN = false, KEEP_ACC = false;
    bf16_t* O; int ldc; int sig_pn0; const float* ssq; bf16_t* rat; int Trows;
    __device__ __forceinline__ void operator()(const f32x4 (&acc)[2][2][4][2], const Unit& u, int wr, int wc, int fr, int fq) const {
        const int row0 = u.pm * BM + wr * 64 + fr; const int col0 = u.pn * BM + wc * 32 + 8 * fq;
        const bool sg = u.pn >= sig_pn0;
        float rs8[2][4]; rows_rstd8(ssq, row0, fq, rs8);
#pragma unroll
        for (int ai = 0; ai < 2; ++ai)
#pragma unroll
            for (int m = 0; m < 4; ++m) { bf16_t* rowp = O + (size_t)(row0 + ai * HALF + m * 16) * ldc + col0;
                const float rs_ = rs8[ai][m];
                f32x4 g0 = acc[ai][0][m][0] * rs_, g1 = acc[ai][0][m][1] * rs_, g2 = acc[ai][1][m][0] * rs_, g3 = acc[ai][1][m][1] * rs_;
                if (sg) {
#pragma unroll
                    for (int j = 0; j < 4; ++j) {
                        const float e0 = fminf(1.0f + __builtin_amdgcn_exp2f(-1.4426950408889634f * g0[j]), 1e6f), e1 = fminf(1.0f + __builtin_amdgcn_exp2f(-1.4426950408889634f * g1[j]), 1e6f);
                        const float e2 = fminf(1.0f + __builtin_amdgcn_exp2f(-1.4426950408889634f * g2[j]), 1e6f), e3 = fminf(1.0f + __builtin_amdgcn_exp2f(-1.4426950408889634f * g3[j]), 1e6f);
                        g0[j] = e1 * __builtin_amdgcn_rcpf(e0); g1[j] = e2 * __builtin_amdgcn_rcpf(e1); g2[j] = e3 * __builtin_amdgcn_rcpf(e2); g3[j] = __builtin_amdgcn_rcpf(e3); }
                }
                if (sg) { typedef unsigned u32x2 __attribute__((ext_vector_type(2)));
                    bf16_t* rp = rat + (size_t)(row0 + ai * HALF + m * 16) * 1024 + (u.pn - sig_pn0) * 64 + 16 * wc + 4 * fq; const size_t pl = (size_t)Trows * 1024;
                    { u32x2 w; w.x = cvt_pk_bf16(g0[0], g0[1]); w.y = cvt_pk_bf16(g0[2], g0[3]); *(u32x2*)rp = w; }
                    { u32x2 w; w.x = cvt_pk_bf16(g1[0], g1[1]); w.y = cvt_pk_bf16(g1[2], g1[3]); *(u32x2*)(rp + pl) = w; }
                    { u32x2 w; w.x = cvt_pk_bf16(g2[0], g2[1]); w.y = cvt_pk_bf16(g2[2], g2[3]); *(u32x2*)(rp + 2 * pl) = w; }
                    { u32x2 w; w.x = cvt_pk_bf16(g3[0], g3[1]); w.y = cvt_pk_bf16(g3[2], g3[3]); *(u32x2*)(rp + 3 * pl) = w; } }
                else {
                { u32x4 w; w.x = cvt_pk_bf16(g0[0], g0[1]); w.y = cvt_pk_bf16(g0[2], g0[3]); w.z = cvt_pk_bf16(g1[0], g1[1]); w.w = cvt_pk_bf16(g1[2], g1[3]); *(u32x4*)rowp = w; }
                { u32x4 w; w.x = cvt_pk_bf16(g2[0], g2[1]); w.y = cvt_pk_bf16(g2[2], g2[3]); w.z = cvt_pk_bf16(g3[0], g3[1]); w.w = cvt_pk_bf16(g3[2], g3[3]); *(u32x4*)(rowp + HALF) = w; } } }
    }
};
struct EpiBranch {
    static constexpr bool PERM = true, AFTER_DRAIN = false, KEEP_ACC = true;
    const bf16_t* rat; int Trows; bf16_t* mb; int nM;
    __device__ __forceinline__ void operator()(f32x4 (&acc)[2][2][4][2], const Unit& u, int wr, int wc, int fr, int fq) const {
        const int i = u.pn >> 2, pn = u.pn & 3, pm = u.pm - i * nM;
        { const int t_ = otid(), l_ = t_ & 63, w_ = t_ >> 6; wr = w_ >> 2; wc = w_ & 3; fr = l_ & 15; fq = l_ >> 4; }
        const int row0 = pm * BM + wr * 64 + fr; const int col0 = pn * BM + wc * 32 + 8 * fq;
        u32x4 gwv[2][4][2];
#pragma unroll
        for (int ai = 0; ai < 2; ++ai)
#pragma unroll
            for (int m = 0; m < 4; ++m) { const bf16_t* grow = rat + ((size_t)i * Trows + (row0 + ai * HALF + m * 16)) * 1024 + col0;
#pragma unroll
                for (int bj = 0; bj < 2; ++bj) gwv[ai][m][bj] = *(const u32x4*)(grow + bj * HALF); }
#pragma unroll
        for (int ai = 0; ai < 2; ++ai)
#pragma unroll
            for (int m = 0; m < 4; ++m) { bf16_t* brow = mb + (size_t)(row0 + ai * HALF + m * 16) * 1024 + col0;
#pragma unroll
                for (int bj = 0; bj < 2; ++bj) { const u32x4 gw = gwv[ai][m][bj]; u32x4 w;
#pragma unroll
                    for (int n = 0; n < 2; ++n) { const unsigned lo = gw[2 * n], hi_ = gw[2 * n + 1];
                        f32x4 g; g[0] = __uint_as_float(lo << 16); g[1] = __uint_as_float(lo & 0xffff0000u); g[2] = __uint_as_float(hi_ << 16); g[3] = __uint_as_float(hi_ & 0xffff0000u);
                        const f32x4 v = acc[ai][bj][m][n] * g; acc[ai][bj][m][n] = v;
                        w[2 * n] = cvt_pk_bf16(v[0], v[1]); w[2 * n + 1] = cvt_pk_bf16(v[2], v[3]); }
                    if (i == 3) *(u32x4*)(brow + bj * HALF) = w; } }
    }
};
__device__ __forceinline__ float dpp_ror1(float x) { return __builtin_bit_cast(float, __builtin_amdgcn_update_dpp(0, __builtin_bit_cast(int, x), 0x121, 0xf, 0xf, false)); }
__device__ __forceinline__ float dpp_ror15(float x) { return __builtin_bit_cast(float, __builtin_amdgcn_update_dpp(0, __builtin_bit_cast(int, x), 0x12F, 0xf, 0xf, false)); }
struct EpiFfn {
    static constexpr bool PERM = true, AFTER_DRAIN = false, KEEP_ACC = false;
    bf16_t* act; float* edge; const float* ssq; const float* cw; const float* cb; int nblk;
    __device__ __forceinline__ void operator()(const f32x4 (&acc)[2][2][4][2], const Unit& u, int wr, int wc, int fr, int fq) const {
        typedef unsigned u32x2 __attribute__((ext_vector_type(2)));
        { const int t_ = otid(), l_ = t_ & 63, w_ = t_ >> 6; wr = w_ >> 2; wc = w_ & 3; fr = l_ & 15; fq = l_ >> 4; }
        const int row0 = u.pm * BM + wr * 64 + fr; const int ch0 = u.pn * 128 + wc * 32 + 8 * fq;
        constexpr bool r1up = true;
        const size_t esz = (size_t)nblk * 2 * 2816;
        float rs8[2][4]; rows_rstd8(ssq, row0, fq, rs8);
        f32x4 cwv[2][4];
#pragma unroll
        for (int n = 0; n < 2; ++n) { const int ch = ch0 + 4 * n; cwv[n][0] = *(const f32x4*)(cw + ch); cwv[n][1] = *(const f32x4*)(cw + 2816 + ch); cwv[n][2] = *(const f32x4*)(cw + 2 * 2816 + ch); cwv[n][3] = *(const f32x4*)(cb + ch); }
#pragma unroll
        for (int ai = 0; ai < 2; ++ai) {
            const int blk = (u.pm * BM + ai * HALF + wr * 64) >> 6;
            f32x4 ua_prev[2], db_next[2], gcur[2];
#pragma unroll
            for (int n = 0; n < 2; ++n) { gcur[n] = acc[ai][1][0][n] * rs8[ai][0]; ua_prev[n] = (f32x4){0.f, 0.f, 0.f, 0.f};
#pragma unroll
                for (int j = 0; j < 4; ++j) db_next[n][j] = dpp_ror15(gcur[n][j]); }
#pragma unroll
            for (int m = 0; m < 4; ++m) { f32x4 ua[2], db[2], gnext[2]; u32x4 w4; f32x4 cvs[2], uus[2];
                const bool isF = (m == 0) && (fr == 0), isL = (m == 3) && (fr == 15);
#pragma unroll
                for (int n = 0; n < 2; ++n) { db[n] = db_next[n];
#pragma unroll
                    for (int j = 0; j < 4; ++j) ua[n][j] = dpp_ror1(gcur[n][j]);
                    if (m < 3) { gnext[n] = acc[ai][1][m < 3 ? m + 1 : 3][n] * rs8[ai][m < 3 ? m + 1 : 3];
#pragma unroll
                        for (int j = 0; j < 4; ++j) db_next[n][j] = dpp_ror15(gnext[n][j]); }
                    else { gnext[n] = (f32x4){0.f, 0.f, 0.f, 0.f}; db_next[n] = gnext[n]; }
                    const f32x4 w0 = cwv[n][0], w1 = cwv[n][1], w2 = cwv[n][2], bb = cwv[n][3]; const f32x4 uu = acc[ai][0][m][n] * rs8[ai][m]; f32x4 cv;
#pragma unroll
                    for (int j = 0; j < 4; ++j) { const float up = (fr > 0) ? ua[n][j] : ua_prev[n][j]; const float dn = (fr < 15) ? db[n][j] : db_next[n][j];
                        cv[j] = w0[j] * up + w1[j] * gcur[n][j] + w2[j] * dn + bb[j]; }
                    cvs[n] = cv; uus[n] = uu;
                    f32x4 a4;
#pragma unroll
                    for (int j = 0; j < 4; ++j) a4[j] = cv[j] * sigm(cv[j]) * uu[j];
                    w4[2 * n] = cvt_pk_bf16(a4[0], a4[1]); w4[2 * n + 1] = cvt_pk_bf16(a4[2], a4[3]); }
                if (isF || isL) { float* e = edge + ((size_t)blk * 2 + (isL ? 1 : 0)) * 2816 + ch0;
#pragma unroll
                    for (int n = 0; n < 2; ++n) { *(f32x4*)(e + 4 * n) = cvs[n]; *(f32x4*)(e + esz + 4 * n) = uus[n]; *(f32x4*)(e + 2 * esz + 4 * n) = gcur[n]; } }
                else *(u32x4*)(act + (size_t)(row0 + ai * HALF + m * 16) * 2816 + ch0) = w4;
#pragma unroll
                for (int n = 0; n < 2; ++n) { ua_prev[n] = ua[n]; gcur[n] = gnext[n]; }
            }
            asm volatile("" ::: "memory");
        }
    }
};
struct EpiResid {
    static constexpr bool PERM = true, AFTER_DRAIN = false, KEEP_ACC = false;
    bf16_t* xr; float* ssq;
    __device__ __forceinline__ void operator()(const f32x4 (&acc)[2][2][4][2], const Unit& u, int wr, int wc, int fr, int fq) const {
        const int row0 = u.pm * BM + wr * 64 + fr; const int col0 = u.pn * BM + wc * 32 + 8 * fq;
        u32x4 owv[2][4][2];
#pragma unroll
        for (int ai = 0; ai < 2; ++ai)
#pragma unroll
            for (int m = 0; m < 4; ++m) { const bf16_t* xp = xr + (size_t)(row0 + ai * HALF + m * 16) * 1024 + col0;
#pragma unroll
                for (int bj = 0; bj < 2; ++bj) owv[ai][m][bj] = *(const u32x4*)(xp + bj * HALF); }
#pragma unroll
        for (int ai = 0; ai < 2; ++ai)
#pragma unroll
            for (int m = 0; m < 4; ++m) { const int row = row0 + ai * HALF + m * 16; bf16_t* xp = xr + (size_t)row * 1024 + col0; float sq = 0.f;
#pragma unroll
                for (int bj = 0; bj < 2; ++bj) { const u32x4 ow = owv[ai][m][bj]; u32x4 w;
#pragma unroll
                    for (int n = 0; n < 2; ++n) { f32x4 v = acc[ai][bj][m][n]; const unsigned lo = ow[2 * n], hi_ = ow[2 * n + 1];
                        v[0] += __uint_as_float(lo << 16); v[1] += __uint_as_float(lo & 0xffff0000u); v[2] += __uint_as_float(hi_ << 16); v[3] += __uint_as_float(hi_ & 0xffff0000u);
                        sq += (v[0] * v[0] + v[1] * v[1]) + (v[2] * v[2] + v[3] * v[3]);
                        w[2 * n] = cvt_pk_bf16(v[0], v[1]); w[2 * n + 1] = cvt_pk_bf16(v[2], v[3]); }
                    *(u32x4*)(xp + bj * HALF) = w; }
                sq += __shfl_xor(sq, 16); sq += __shfl_xor(sq, 32);
                if (fq == 0) ssq[(size_t)row * 16 + u.pn * 4 + wc] = sq; }
    }
};
struct BranchOrder {
    int nM, G, c;
    __device__ bool next(int i, Unit& u) const { const int tl = (i >> 2) * G + c; if (tl >= nM * 4) return false; const int sub = i & 3; u.pm = sub * nM + (tl >> 2); u.pn = sub * 4 + (tl & 3); return true; }
    __device__ __forceinline__ void a_ready(const Unit&) const {}
    __device__ __forceinline__ void done(const Unit&) const {}
};

template <class Epi, class Sched, bool ALIGN_EPI = false, bool SP2 = false>
__device__ __forceinline__ void gemm_phase(PG8_LAS unsigned char* lds, const Gemm g, const Sched& S, const Epi& E) {
    const int tid = otid(), wid = __builtin_amdgcn_readfirstlane(tid >> 6), lane = tid & 63, wr = wid >> 2, wc = wid & 3, fr = lane & 15, fq = lane >> 4;
    const int K = g.K, nt = K / BK;
    unsigned voffA[2], voffB[2];
#pragma unroll
    for (int i = 0; i < 2; ++i) { int R, C; stage_rc(tid * 16 + i * 8192, R, C); const int Rb = Epi::PERM ? ((R & ~31) + perm32(R & 31)) : R;
        voffA[i] = (unsigned)(R * K + C) * 2u; voffB[i] = (unsigned)(Rb * K + C) * 2u; }
    const size_t kstep = (size_t)(BK * 2);
    const size_t hstep = (size_t)HALF * K * 2;
    const size_t tstep = 2 * hstep;
    const unsigned ldsw = (unsigned)wid * 1024u;
    const int aoff = lds_byte(wr * 64 + fr, fq * 8), boff = lds_byte(wc * 32 + fr, fq * 8);
#define PG8_SA(b, h) (((b) * 2 + (h)) * HTB)
#define PG8_SB(b, h) ((4 + (b) * 2 + (h)) * HTB)
#define PG8_STAGE(bufoff, gbase, voff) do { _Pragma("unroll") for (int _i = 0; _i < 2; ++_i) \
        __builtin_amdgcn_global_load_lds((const unsigned*)((const char*)(gbase) + (voff)[_i]), (PG8_LAS unsigned*)(lds + (bufoff) + ldsw + _i * 8192), 16, 0, 0); } while (0)
#define PG8_LDA(dst, b, h) do { _Pragma("unroll") for (int m = 0; m < 4; ++m) _Pragma("unroll") for (int k = 0; k < 2; ++k) dst[m][k] = *(const PG8_LAS bf16x8*)(lds + PG8_SA(b, h) + aoff + m * 2048 + k * 1024); } while (0)
#define PG8_LDB(dst, b, h) do { _Pragma("unroll") for (int n = 0; n < 2; ++n) _Pragma("unroll") for (int k = 0; k < 2; ++k) dst[n][k] = *(const PG8_LAS bf16x8*)(lds + PG8_SB(b, h) + boff + n * 2048 + k * 1024); } while (0)
#define PG8_MMA(ai, bj, At, Bt) do { __builtin_amdgcn_s_setprio(1); _Pragma("unroll") for (int m = 0; m < 4; ++m) _Pragma("unroll") for (int n = 0; n < 2; ++n) _Pragma("unroll") for (int k = 0; k < 2; ++k) \
        acc[ai][bj][m][n] = __builtin_amdgcn_mfma_f32_16x16x32_bf16(Bt[n][k], At[m][k], acc[ai][bj][m][n], 0, 0, 0); __builtin_amdgcn_s_setprio(0); } while (0)
#define PG8_WAIT_V(n) asm volatile("s_waitcnt vmcnt(" #n ")" ::: "memory")
#define PG8_WAIT_L(n) asm volatile("s_waitcnt lgkmcnt(" #n ")" ::: "memory")
#define PG8_BAR __builtin_amdgcn_s_barrier()
#define PG8_SCHED __builtin_amdgcn_sched_barrier(0)
    Unit cur, nxt; int ui = 0;
    if (!S.next(0, cur)) return;
    f32x4 acc[2][2][4][2];
#pragma unroll
    for (int a = 0; a < 2; ++a)
#pragma unroll
        for (int b = 0; b < 2; ++b)
#pragma unroll
            for (int m = 0; m < 4; ++m)
#pragma unroll
                for (int n = 0; n < 2; ++n) acc[a][b][m][n] = (f32x4){0.f, 0.f, 0.f, 0.f};
    bf16x8 At[4][2], B0[2][2], B1[2][2];
    const char* cA = (const char*)g.A + (size_t)cur.pm * tstep; const char* cB = (const char*)g.Bt + (size_t)cur.pn * tstep;
    S.a_ready(cur);
    if constexpr (SP2) {
        PG8_STAGE(PG8_SB(0, 0), cB, voffB); PG8_STAGE(PG8_SB(0, 1), cB + hstep, voffB); PG8_STAGE(PG8_SA(0, 0), cA, voffA); PG8_STAGE(PG8_SA(0, 1), cA + hstep, voffA);
        if (wr == 1) PG8_BAR;
        PG8_WAIT_V(2); PG8_BAR;
        PG8_STAGE(PG8_SB(1, 0), cB + kstep, voffB); PG8_STAGE(PG8_SA(1, 0), cA + kstep, voffA); PG8_STAGE(PG8_SB(1, 1), cB + hstep + kstep, voffB);
        PG8_WAIT_V(6); PG8_BAR;
    } else {
        PG8_STAGE(PG8_SB(0, 0), cB, voffB); PG8_STAGE(PG8_SA(0, 0), cA, voffA); PG8_STAGE(PG8_SB(0, 1), cB + hstep, voffB); PG8_STAGE(PG8_SA(0, 1), cA + hstep, voffA);
        if (wr == 1) PG8_BAR;
        PG8_WAIT_V(4); PG8_BAR;
        PG8_STAGE(PG8_SB(1, 0), cB + kstep, voffB); PG8_STAGE(PG8_SA(1, 0), cA + kstep, voffA); PG8_STAGE(PG8_SB(1, 1), cB + hstep + kstep, voffB);
        PG8_WAIT_V(6); PG8_BAR;
    }
    for (;;) {
        const bool has_next = S.next(ui + 1, nxt);
        const char* nA = has_next ? (const char*)g.A + (size_t)nxt.pm * tstep : cA; const char* nB = has_next ? (const char*)g.Bt + (size_t)nxt.pn * tstep : cB;
        for (int t = 0; t < nt; t += 2) {
            const bool last = (t == nt - 2);
            const char* a1 = cA + (size_t)(t + 1) * kstep;
            const char* a2 = last ? nA : cA + (size_t)(t + 2) * kstep; const char* b2 = last ? nB : cB + (size_t)(t + 2) * kstep;
            const char* a3 = a2 + kstep; const char* b3 = b2 + kstep;
            if (last && has_next) S.a_ready(nxt);
            if constexpr (SP2) {
            PG8_LDB(B0, 0, 0); PG8_LDB(B1, 0, 1); PG8_SCHED; PG8_LDA(At, 0, 0); PG8_STAGE(PG8_SA(1, 1), a1 + hstep, voffA);
            PG8_WAIT_V(8); PG8_WAIT_L(0); PG8_BAR; PG8_MMA(0, 0, At, B0); PG8_MMA(0, 1, At, B1); PG8_BAR; PG8_SCHED;
            PG8_LDA(At, 0, 1); PG8_STAGE(PG8_SB(0, 0), b2, voffB); PG8_STAGE(PG8_SB(0, 1), b2 + hstep, voffB); PG8_STAGE(PG8_SA(0, 0), a2, voffA);
            PG8_WAIT_V(8); PG8_WAIT_L(0); PG8_BAR; PG8_MMA(1, 0, At, B0); PG8_MMA(1, 1, At, B1); PG8_BAR; PG8_SCHED;
            PG8_LDB(B0, 1, 0); PG8_LDB(B1, 1, 1); PG8_SCHED; PG8_LDA(At, 1, 0); PG8_STAGE(PG8_SA(0, 1), a2 + hstep, voffA);
            PG8_WAIT_V(8); PG8_WAIT_L(0); PG8_BAR; PG8_MMA(0, 0, At, B0); PG8_MMA(0, 1, At, B1); PG8_BAR; PG8_SCHED;
            PG8_LDA(At, 1, 1); PG8_STAGE(PG8_SB(1, 0), b3, voffB); PG8_STAGE(PG8_SB(1, 1), b3 + hstep, voffB); PG8_STAGE(PG8_SA(1, 0), a3, voffA);
            PG8_WAIT_V(8); PG8_WAIT_L(0); PG8_BAR; PG8_MMA(1, 0, At, B0); PG8_MMA(1, 1, At, B1); PG8_BAR; PG8_SCHED;
            } else {
            PG8_LDB(B0, 0, 0); PG8_SCHED; PG8_LDA(At, 0, 0); PG8_STAGE(PG8_SA(1, 1), a1 + hstep, voffA);
            PG8_WAIT_L(8); PG8_BAR; PG8_WAIT_L(0); PG8_MMA(0, 0, At, B0); PG8_BAR; PG8_SCHED;
            PG8_LDB(B1, 0, 1); PG8_STAGE(PG8_SB(0, 0), b2, voffB);
            PG8_BAR; PG8_WAIT_L(0); PG8_MMA(0, 1, At, B1); PG8_BAR;
            PG8_LDA(At, 0, 1); PG8_STAGE(PG8_SA(0, 0), a2, voffA);
            PG8_BAR; PG8_WAIT_L(0); PG8_MMA(1, 0, At, B0); PG8_BAR; PG8_SCHED;
            PG8_STAGE(PG8_SB(0, 1), b2 + hstep, voffB);
            PG8_WAIT_V(6); PG8_BAR; PG8_MMA(1, 1, At, B1); PG8_BAR;
            PG8_LDB(B0, 1, 0); PG8_SCHED; PG8_LDA(At, 1, 0); PG8_STAGE(PG8_SA(0, 1), a2 + hstep, voffA);
            PG8_WAIT_L(8); PG8_BAR; PG8_WAIT_L(0); PG8_MMA(0, 0, At, B0); PG8_BAR; PG8_SCHED;
            PG8_LDB(B1, 1, 1); PG8_STAGE(PG8_SB(1, 0), b3, voffB);
            PG8_BAR; PG8_WAIT_L(0); PG8_MMA(0, 1, At, B1); PG8_BAR;
            PG8_LDA(At, 1, 1); PG8_STAGE(PG8_SA(1, 0), a3, voffA);
            PG8_BAR; PG8_WAIT_L(0); PG8_MMA(1, 0, At, B0); PG8_BAR; PG8_SCHED;
            PG8_STAGE(PG8_SB(1, 1), b3 + hstep, voffB);
            PG8_WAIT_V(6); PG8_BAR; PG8_MMA(1, 1, At, B1); PG8_BAR;
            }
        }
        if constexpr (ALIGN_EPI) { if (wr == 0) PG8_BAR; }
        if constexpr (!Epi::AFTER_DRAIN) { E(acc, cur, wr, wc, fr, fq); S.done(cur); }
        if (!has_next) break;
        if (!Epi::KEEP_ACC || ((ui + 1) & 3) == 0) {
#pragma unroll
        for (int a = 0; a < 2; ++a)
#pragma unroll
            for (int b = 0; b < 2; ++b)
#pragma unroll
                for (int m = 0; m < 4; ++m)
#pragma unroll
                    for (int n = 0; n < 2; ++n) acc[a][b][m][n] = (f32x4){0.f, 0.f, 0.f, 0.f};
        }
        cur = nxt; cA = nA; cB = nB; ++ui;
        if constexpr (ALIGN_EPI) { if (wr == 1) PG8_BAR; }
    }
    PG8_WAIT_V(0);
    if constexpr (!ALIGN_EPI) { if (wr == 0) PG8_BAR; }
    PG8_BAR;
    if constexpr (Epi::AFTER_DRAIN) { E.fused(acc, cur, wr, wc, fr, fq, lds, wid, lane); S.done(cur); }
#undef PG8_SA
#undef PG8_SB
#undef PG8_STAGE
#undef PG8_LDA
#undef PG8_LDB
#undef PG8_MMA
#undef PG8_WAIT_V
#undef PG8_WAIT_L
#undef PG8_BAR
#undef PG8_SCHED
}
}
#define LAS __attribute__((address_space(3)))
typedef unsigned short bf16_t;
typedef short bf16x8 __attribute__((ext_vector_type(8)));
typedef short v4i16_t __attribute__((ext_vector_type(4)));
typedef float f32x4 __attribute__((ext_vector_type(4)));
typedef float f32x16 __attribute__((ext_vector_type(16)));
typedef unsigned u32x4 __attribute__((ext_vector_type(4)));
typedef unsigned u32x2 __attribute__((ext_vector_type(2)));
using pg8::cvt_pk_bf16;

constexpr int DM = 1024, SEQ = 2048, NSEQ = 40, NTOK_P = 32 * SEQ, NTOK = NSEQ * SEQ, DEPTH = 2;
constexpr int TMAX = 32768, NGROUP = 3;
constexpr int NPROJ = 6656;
constexpr int PPITCH = 2560;
constexpr int PA = 0, PB = 768, PD = 1536, PC = 2048, PG = 2560;
constexpr int FF = 2816, NUG = 2 * FF;
constexpr float EPS = 1e-6f, LOG2E = 1.4426950408889634f;
constexpr int NWAVES = 8, NTHR = 512;

constexpr size_t al256(size_t x) { return (x + 255) & ~(size_t)255; }
constexpr size_t WS_WIN = 1 << 20;
constexpr size_t WS_WBR = WS_WIN + al256((size_t)DEPTH * NPROJ * DM * 2);
constexpr size_t WS_WOUT = WS_WBR + al256((size_t)DEPTH * 4 * 1024 * 256 * 2);
constexpr size_t WS_WFI = WS_WOUT + al256((size_t)DEPTH * DM * DM * 2);
constexpr size_t WS_WFO = WS_WFI + al256((size_t)DEPTH * NUG * DM * 2);
constexpr size_t WS_WUQ = WS_WFO + al256((size_t)DEPTH * DM * FF * 2);
constexpr size_t WS_WUKV = WS_WUQ + al256((size_t)DEPTH * 384 * 192 * 2);
constexpr size_t WS_ROPE = WS_WUKV + al256((size_t)DEPTH * 512 * 128 * 2);
constexpr size_t WS_XN = WS_ROPE + al256((size_t)2048 * 16 * 8);
constexpr size_t WS_PROJ = WS_XN + al256((size_t)TMAX * DM * 2);
constexpr size_t WS_RAT = WS_PROJ + al256((size_t)TMAX * PPITCH * 2);
constexpr size_t WS_QC = WS_RAT + al256((size_t)4 * TMAX * 1024 * 2);
constexpr size_t WS_KC = WS_QC + al256((size_t)TMAX * 384 * 2);
constexpr size_t WS_VC = WS_KC + al256((size_t)TMAX * 384 * 2);
constexpr size_t WS_OB = WS_VC + al256((size_t)TMAX * 256 * 2);
constexpr size_t WS_MRG = WS_OB + al256((size_t)4 * TMAX * 256 * 2);
constexpr size_t WS_MB = WS_MRG + al256((size_t)48 << 20);
constexpr size_t WS_UG = WS_MB + al256((size_t)TMAX * DM * 2);
constexpr size_t WS_ACT = WS_UG;
constexpr size_t WS_END = WS_ACT + al256((size_t)TMAX * FF * 2);
static_assert(WS_END <= ((size_t)1 << 30), "workspace map exceeds 1 GiB");
static_assert((size_t)64 * TMAX * 4 + (size_t)3 * (TMAX / 64) * 2 * 2816 * 4 <= ((size_t)48 << 20), "MRG region");

constexpr int LDS_BYTES = 135168;

struct Args { const float* in[24]; float* out; unsigned char* ws; };
#ifndef PH_MASK
#define PH_MASK 0xFFFF
#endif
#ifndef FLK
#define FLK 15
#endif
#ifndef DUP_MASK
#define DUP_MASK 0
#endif
#define PH(k) _Pragma("unroll 1") for (int rep_ = 0; rep_ < (int)(((PH_MASK >> (k)) & 1) + ((DUP_MASK >> (k)) & 1)); ++rep_)

__device__ __forceinline__ float bf2f(bf16_t b) { return __uint_as_float((unsigned)b << 16); }
__device__ __forceinline__ bf16_t f2bf(float f) { return (bf16_t)(cvt_pk_bf16(f, 0.f) & 0xffffu); }
__device__ __forceinline__ float wave_sum(float v) {
#pragma unroll
    for (int o = 1; o < 64; o <<= 1) v += __shfl_xor(v, o);
    return v;
}
__device__ __forceinline__ int crow(int r, int hi) { return (r & 3) + 8 * (r >> 2) + 4 * hi; }
__device__ __forceinline__ v4i16_t vtr(LAS const char* p) { return __builtin_amdgcn_ds_read_tr16_b64_v4i16((LAS v4i16_t*)p); }
#define MFMA32(a, b, c) __builtin_amdgcn_mfma_f32_32x32x16_bf16((a), (b), (c), 0, 0, 0)
#define MFMA16(a, b, c) __builtin_amdgcn_mfma_f32_16x16x32_bf16((a), (b), (c), 0, 0, 0)

__device__ __forceinline__ void transpose_item(const float* W, int K, int N, bf16_t* WT, int n0d, int n0s, float scale, int k0, float* scr, int lane, bool gperm = false, const float* kgain = nullptr) {
    if (gperm) {
        const int cg = n0d - PG + (lane & 31), tg = cg >> 8, cc = cg & 255, gi = 2 * (cc >> 7) + ((cc >> 2) & 1), ch = tg * 64 + 16 * ((cc >> 5) & 3) + 4 * ((cc >> 3) & 3) + (cc & 3);
        const int src = 2400 + gi * 1024 + ch;
#pragma unroll
        for (int i = 0; i < 32; ++i) { const int kk = 2 * i + (lane >> 5); scr[kk * 33 + (lane & 31)] = W[(size_t)(k0 + kk) * N + src] * kgain[k0 + kk]; }
    } else if (n0s >= 0) {
#pragma unroll
        for (int i = 0; i < 32; ++i) { const int kk = 2 * i + (lane >> 5); scr[kk * 33 + (lane & 31)] = W[(size_t)(k0 + kk) * N + n0s + (lane & 31)] * (kgain ? scale * kgain[k0 + kk] : scale); }
    } else {
#pragma unroll
        for (int i = 0; i < 32; ++i) { const int kk = 2 * i + (lane >> 5); scr[kk * 33 + (lane & 31)] = 0.f; }
    }
    __builtin_amdgcn_wave_barrier(); asm volatile("s_waitcnt lgkmcnt(0)" ::: "memory");
    const int c = lane & 7;
#pragma unroll
    for (int j = 0; j < 4; ++j) { const int n = (lane >> 3) + 8 * j; const float* s = scr + (8 * c) * 33 + n;
        u32x4 o; o.x = cvt_pk_bf16(s[0 * 33], s[1 * 33]); o.y = cvt_pk_bf16(s[2 * 33], s[3 * 33]); o.z = cvt_pk_bf16(s[4 * 33], s[5 * 33]); o.w = cvt_pk_bf16(s[6 * 33], s[7 * 33]);
        *(u32x4*)(WT + (size_t)(n0d + n) * K + k0 + 8 * c) = o; }
    __builtin_amdgcn_wave_barrier(); asm volatile("s_waitcnt lgkmcnt(0)" ::: "memory");
}
__device__ __forceinline__ void prologue(const Args& a, unsigned char* ws, char* lds, int gw, int NGW, int wave, int lane) {
    float* scr = (float*)(lds + wave * 16384);
    constexpr int I_IN = 16 * (NPROJ / 32), I_BR = 4 * 4 * 32, I_OUT = 16 * 32, I_FI = 16 * (NUG / 32), I_FO = (FF / 64) * 32, I_UQ = 3 * 12, I_UKV = 2 * 16;
    constexpr int PER_L = I_IN + I_BR + I_OUT + I_FI + I_FO + I_UQ + I_UKV;
    for (int it = gw; it < DEPTH * PER_L; it += NGW) {
        const int l = it / PER_L; int r = it % PER_L;
        if (r < I_IN) { const int nb = r % (NPROJ / 32), kb = r / (NPROJ / 32); const int n0d = nb * 32; int n0s; float sc = 1.f;
            if (n0d < PD) { n0s = n0d; if (n0d < 256) sc = 0.17677669529663687f * LOG2E; else if (n0d >= PB && n0d < PB + 256) sc = 0.125f * LOG2E; }
            else if (n0d < PC) n0s = n0d - PD + 1888;
            else if (n0d < PC + 352) n0s = n0d - PC + 1536;
            else if (n0d < PG) n0s = -1;
            else n0s = n0d - PG + 2400;
            transpose_item(a.in[3] + (size_t)l * DM * 6496, DM, 6496, (bf16_t*)(ws + WS_WIN) + (size_t)l * NPROJ * DM, n0d, n0s, sc, kb * 64, scr, lane, n0d >= PG, a.in[2] + l * DM); continue; }
        r -= I_IN;
        if (r < I_BR) { const int i = r / 128, rr = r % 128, nb = rr % 32, kb = rr / 32;
            transpose_item(a.in[16] + ((size_t)l * 4 + i) * 256 * 1024, 256, 1024, (bf16_t*)(ws + WS_WBR) + ((size_t)l * 4 + i) * 1024 * 256, nb * 32, nb * 32, 1.f, kb * 64, scr, lane); continue; }
        r -= I_BR;
        if (r < I_OUT) { const int nb = r % 32, kb = r / 32;
            transpose_item(a.in[17] + (size_t)l * DM * DM, DM, DM, (bf16_t*)(ws + WS_WOUT) + (size_t)l * DM * DM, nb * 32, nb * 32, 1.f, kb * 64, scr, lane); continue; }
        r -= I_OUT;
        if (r < I_FI) { const int nb = r % (NUG / 32), kb = r / (NUG / 32);
            const int n0d = nb * 32, src0 = ((n0d >> 7) & 1) * FF + (n0d >> 8) * 128 + (n0d & 127);
            transpose_item(a.in[19] + (size_t)l * DM * NUG, DM, NUG, (bf16_t*)(ws + WS_WFI) + (size_t)l * NUG * DM, n0d, src0, 1.f, kb * 64, scr, lane, false, a.in[18] + l * DM); continue; }
        r -= I_FI;
        if (r < I_FO) { const int nb = r % 32, kb = r / 32;
            transpose_item(a.in[22] + (size_t)l * FF * DM, FF, DM, (bf16_t*)(ws + WS_WFO) + (size_t)l * DM * FF, nb * 32, nb * 32, 1.f, kb * 64, scr, lane); continue; }
        r -= I_FO;
        if (r < I_UQ) { const int nb = r % 12, kb = r / 12;
            transpose_item(a.in[12] + (size_t)l * 192 * 384, 192, 384, (bf16_t*)(ws + WS_WUQ) + (size_t)l * 384 * 192, nb * 32, nb * 32, 1.f, kb * 64, scr, lane); continue; }
        r -= I_UQ;
        { const int nb = r % 16, kb = r / 16;
            transpose_item(a.in[13] + (size_t)l * 128 * 512, 128, 512, (bf16_t*)(ws + WS_WUKV) + (size_t)l * 512 * 128, nb * 32, nb * 32, 1.f, kb * 64, scr, lane); }
    }
    float2* rope = (float2*)(ws + WS_ROPE);
    for (int e = gw * 64 + lane; e < 2048 * 16; e += NGW * 64) {
        const int pos = e >> 4, i = e & 15;
        const float inv = exp2f(-(float)i * (13.287712379549449f / 16.0f));
        const float ang = (float)pos * inv;
        const double rev = (double)ang * 0.15915494309189535; const double fr = rev - __builtin_rint(rev);
        rope[e] = make_float2(__builtin_amdgcn_cosf((float)fr), __builtin_amdgcn_sinf((float)fr));
    }
}

__device__ __forceinline__ void convert_phase(const float* xa, const float* xb, int row_g0, int T, bf16_t* XR, float* S0, int gw, int NGW, int lane) {
#pragma unroll 1
    for (int m0 = gw; m0 < T; m0 += 2 * NGW) { const int m1 = (m0 + NGW < T) ? m0 + NGW : m0;
        f32x4 v[2][4];
#pragma unroll
        for (int k = 0; k < 2; ++k) { const int R = row_g0 + (k ? m1 : m0); const float* xr = (R < NTOK_P) ? xa + (size_t)R * DM : xb + (size_t)(R - NTOK_P) * DM;
#pragma unroll
            for (int j = 0; j < 4; ++j) v[k][j] = ((const f32x4*)xr)[lane + 64 * j]; }
#pragma unroll
        for (int k = 0; k < 2; ++k) { const int m = k ? m1 : m0; float s = 0.f;
#pragma unroll
            for (int j = 0; j < 4; ++j) s += (v[k][j].x * v[k][j].x + v[k][j].y * v[k][j].y) + (v[k][j].z * v[k][j].z + v[k][j].w * v[k][j].w);
            s = wave_sum(s);
            u32x2* o8 = (u32x2*)(XR + (size_t)m * DM);
#pragma unroll
            for (int j = 0; j < 4; ++j) { u32x2 w; w.x = cvt_pk_bf16(v[k][j].x, v[k][j].y); w.y = cvt_pk_bf16(v[k][j].z, v[k][j].w); o8[lane + 64 * j] = w; }
            if (lane < 16) S0[(size_t)m * 16 + lane] = (lane == 0) ? s : 0.f; }
    }
}
__device__ __forceinline__ void final_norm_phase(float* out, int row_g0, int T, const bf16_t* XR, const float* S0, const float* gain, int gw, int NGW, int lane) {
    f32x4 g[4];
#pragma unroll
    for (int j = 0; j < 4; ++j) g[j] = ((const f32x4*)gain)[lane + 64 * j];
#pragma unroll 1
    for (int m0 = gw; m0 < T; m0 += 2 * NGW) { const int m1 = (m0 + NGW < T) ? m0 + NGW : m0;
        u32x2 w[2][4]; f32x4 sp[2][4];
#pragma unroll
        for (int k = 0; k < 2; ++k) { const int m = k ? m1 : m0; const u32x2* x8 = (const u32x2*)(XR + (size_t)m * DM);
#pragma unroll
            for (int j = 0; j < 4; ++j) { w[k][j] = x8[lane + 64 * j]; sp[k][j] = ((const f32x4*)(S0 + (size_t)m * 16))[j]; } }
#pragma unroll
        for (int k = 0; k < 2; ++k) { const int m = k ? m1 : m0; float* orow = out + (size_t)(row_g0 + m) * DM;
            const float sq_ = (((sp[k][0][0] + sp[k][0][1]) + (sp[k][0][2] + sp[k][0][3])) + ((sp[k][1][0] + sp[k][1][1]) + (sp[k][1][2] + sp[k][1][3]))) + (((sp[k][2][0] + sp[k][2][1]) + (sp[k][2][2] + sp[k][2][3])) + ((sp[k][3][0] + sp[k][3][1]) + (sp[k][3][2] + sp[k][3][3])));
            const float rstd = 1.0f / sqrtf(sq_ * (1.f / DM) + EPS);
#pragma unroll
            for (int j = 0; j < 4; ++j) { f32x4 v; v.x = __uint_as_float(w[k][j].x << 16) * rstd * g[j].x; v.y = __uint_as_float(w[k][j].x & 0xffff0000u) * rstd * g[j].y; v.z = __uint_as_float(w[k][j].y << 16) * rstd * g[j].z; v.w = __uint_as_float(w[k][j].y & 0xffff0000u) * rstd * g[j].w;
                ((f32x4*)orow)[lane + 64 * j] = v; } }
    }
}
__device__ __forceinline__ void conv_fix_phase(const float* edge, bf16_t* ACT, const float* cw, int T, int gtid, int NT) {
    constexpr int NCH = FF / 8; const int NBLK = T / 64; const size_t esz = (size_t)NBLK * 2 * FF;
#pragma unroll 1
    for (int idx = gtid; idx < NBLK * 2 * NCH; idx += NT) { const int ch = (idx % NCH) * 8, bw = idx / NCH, which = bw & 1, blk = bw >> 1;
        const int row = blk * 64 + (which ? 63 : 0), pos = row & (SEQ - 1);
        const bool nb_ok = which ? (pos < SEQ - 1) : (pos > 0);
        const float* e = edge + (size_t)bw * FF + ch; const float* wv = cw + (which ? 2 * FF : 0) + ch;
        const float* gn = edge + 2 * esz + (size_t)(which ? (blk + 1) * 2 : (blk - 1) * 2 + 1) * FF + ch;
        u32x4 o;
#pragma unroll
        for (int q = 0; q < 2; ++q) { const f32x4 cv = ((const f32x4*)e)[q], uu = ((const f32x4*)(e + esz))[q], wq = ((const f32x4*)wv)[q]; f32x4 gq = {0.f, 0.f, 0.f, 0.f}; if (nb_ok) gq = ((const f32x4*)gn)[q];
            float r[4];
#pragma unroll
            for (int j = 0; j < 4; ++j) { const float c = cv[j] + wq[j] * gq[j]; r[j] = c * pg8::sigm(c) * uu[j]; }
            o[2 * q] = cvt_pk_bf16(r[0], r[1]); o[2 * q + 1] = cvt_pk_bf16(r[2], r[3]); }
        *(u32x4*)(ACT + (size_t)row * FF + ch) = o; }
}

template <int NTK>
__device__ __forceinline__ void pp_elem(const int (&toks)[NTK], bf16_t* PROJ, bf16_t* KC, const float2* rope, const float* dqn, const float* dkn, int lane) {
    int e0, c, sec = 0; bool isD = false; float sc = 1.f; const float* gn = dqn;
    if (lane < 32) { sec = lane >> 1; c = lane & 1; e0 = PA + sec * 32 + c * 8; }
    else if (lane < 56) { const int t = lane - 32, hd = t >> 2; sec = (t >> 1) & 1; c = t & 1; e0 = PD + hd * 64 + sec * 32 + c * 8; isD = true; gn = ((hd < 4) ? dqn : dkn) + sec * 32 + c * 8; sc = (hd < 4) ? 0.125f * LOG2E : 1.f; }
    else { c = lane & 1; e0 = PC + 320 + c * 8; }
    const bool active = lane < 58, isC = lane >= 56;
    u32x4 xa[NTK], xb[NTK]; f32x4 rp[NTK][4];
#pragma unroll
    for (int k = 0; k < NTK; ++k) { const int tok = toks[k], pos = tok & (SEQ - 1); const bf16_t* row = PROJ + (size_t)tok * PPITCH + e0;
        const int pe = isD ? (sec ? (pos & 63) : (pos >> 6)) : pos; const f32x4* rq = (const f32x4*)(rope + pe * 16 + c * 8);
        if (active) { xa[k] = *(const u32x4*)row; xb[k] = *(const u32x4*)(row + 16); } else { xa[k] = (u32x4){0u, 0u, 0u, 0u}; xb[k] = xa[k]; }
#pragma unroll
        for (int q = 0; q < 4; ++q) rp[k][q] = rq[q]; }
    f32x4 g1[2], g2[2];
#pragma unroll
    for (int q = 0; q < 2; ++q) { g1[q] = *(const f32x4*)(gn + 4 * q); g2[q] = *(const f32x4*)(gn + 16 + 4 * q); }
#pragma unroll
    for (int k = 0; k < NTK; ++k) { const int tok = toks[k];
        float x1[8], x2[8]; float ss = 0.f;
#pragma unroll
        for (int q = 0; q < 4; ++q) { x1[2 * q] = __uint_as_float(xa[k][q] << 16); x1[2 * q + 1] = __uint_as_float(xa[k][q] & 0xffff0000u); x2[2 * q] = __uint_as_float(xb[k][q] << 16); x2[2 * q + 1] = __uint_as_float(xb[k][q] & 0xffff0000u); }
#pragma unroll
        for (int j = 0; j < 8; ++j) ss += x1[j] * x1[j] + x2[j] * x2[j];
        ss += __shfl_xor(ss, 1); ss += __shfl_xor(ss, 2);
        if (isD) { const float rstd = 1.0f / sqrtf(ss * (1.f / 64.f) + EPS);
#pragma unroll
            for (int j = 0; j < 8; ++j) { x1[j] *= rstd * g1[j >> 2][j & 3]; x2[j] *= rstd * g2[j >> 2][j & 3]; } }
        u32x4 oa, ob;
#pragma unroll
        for (int q = 0; q < 4; ++q) { const float c0 = rp[k][q][0], s0 = rp[k][q][1], c1 = rp[k][q][2], s1 = rp[k][q][3];
            oa[q] = cvt_pk_bf16((x1[2 * q] * c0 - x2[2 * q] * s0) * sc, (x1[2 * q + 1] * c1 - x2[2 * q + 1] * s1) * sc);
            ob[q] = cvt_pk_bf16((x2[2 * q] * c0 + x1[2 * q] * s0) * sc, (x2[2 * q + 1] * c1 + x1[2 * q + 1] * s1) * sc); }
        if (active) {
            if (isC) { bf16_t* kc = KC + (size_t)tok * 384 + 64 + c * 8;
#pragma unroll
                for (int hh = 0; hh < 4; ++hh) { *(u32x4*)(kc + hh * 96) = oa; *(u32x4*)(kc + hh * 96 + 16) = ob; } }
            else { bf16_t* row = PROJ + (size_t)tok * PPITCH + e0; *(u32x4*)row = oa; *(u32x4*)(row + 16) = ob; } }
    }
}
__device__ __forceinline__ void pp_mla(int tok0, int hp, const bf16_t* PROJ, bf16_t* QC, bf16_t* KC, bf16_t* VC, const float2* rope, const bf16_t* WuqT, const bf16_t* WukvT, const float* cqn, const float* ckvn, int lane) {
    const int m = lane & 15, quad = lane >> 4, tok = tok0 + m, pos = tok & (SEQ - 1);
    const bf16_t* crow_ = PROJ + (size_t)tok * PPITCH + PC;
    bf16x8 aq[6], ak[4]; float ssq_ = 0.f, ssk_ = 0.f;
#pragma unroll
    for (int ks = 0; ks < 6; ++ks) aq[ks] = *(const bf16x8*)(crow_ + ks * 32 + quad * 8);
#pragma unroll
    for (int ks = 0; ks < 4; ++ks) ak[ks] = *(const bf16x8*)(crow_ + 192 + ks * 32 + quad * 8);
#pragma unroll
    for (int ks = 0; ks < 6; ++ks)
#pragma unroll
        for (int e = 0; e < 8; ++e) { const float x = bf2f((bf16_t)aq[ks][e]); ssq_ += x * x; }
#pragma unroll
    for (int ks = 0; ks < 4; ++ks)
#pragma unroll
        for (int e = 0; e < 8; ++e) { const float x = bf2f((bf16_t)ak[ks][e]); ssk_ += x * x; }
    ssq_ += __shfl_xor(ssq_, 16); ssq_ += __shfl_xor(ssq_, 32); ssk_ += __shfl_xor(ssk_, 16); ssk_ += __shfl_xor(ssk_, 32);
    const float rq = 1.0f / sqrtf(ssq_ * (1.f / 192.f) + EPS), rk = 1.0f / sqrtf(ssk_ * (1.f / 128.f) + EPS);
#pragma unroll
    for (int ks = 0; ks < 6; ++ks) { u32x4 w; const f32x4 ga = *(const f32x4*)(cqn + ks * 32 + quad * 8), gb = *(const f32x4*)(cqn + ks * 32 + quad * 8 + 4);
#pragma unroll
        for (int e = 0; e < 4; ++e) { const float g0 = e < 2 ? ga[2 * e] : gb[2 * e - 4], g1 = e < 2 ? ga[2 * e + 1] : gb[2 * e - 3]; w[e] = cvt_pk_bf16(bf2f((bf16_t)aq[ks][2 * e]) * rq * g0, bf2f((bf16_t)aq[ks][2 * e + 1]) * rq * g1); }
        aq[ks] = __builtin_bit_cast(bf16x8, w); }
#pragma unroll
    for (int ks = 0; ks < 4; ++ks) { u32x4 w; const f32x4 ga = *(const f32x4*)(ckvn + ks * 32 + quad * 8), gb = *(const f32x4*)(ckvn + ks * 32 + quad * 8 + 4);
#pragma unroll
        for (int e = 0; e < 4; ++e) { const float g0 = e < 2 ? ga[2 * e] : gb[2 * e - 4], g1 = e < 2 ? ga[2 * e + 1] : gb[2 * e - 3]; w[e] = cvt_pk_bf16(bf2f((bf16_t)ak[ks][2 * e]) * rk * g0, bf2f((bf16_t)ak[ks][2 * e + 1]) * rk * g1); }
        ak[ks] = __builtin_bit_cast(bf16x8, w); }
    const float qs = 0.10206207261596577f * LOG2E;
    f32x4 cs4[2];
#pragma unroll
    for (int q = 0; q < 2; ++q) cs4[q] = *(const f32x4*)(rope + pos * 16 + quad * 4 + 2 * q);
#pragma unroll 1
    for (int hi_ = 0; hi_ < 2; ++hi_) { const int hh = 2 * hp + hi_;
        {   f32x4 acc[6];
#pragma unroll
            for (int nt = 0; nt < 6; ++nt) { acc[nt] = (f32x4){0.f, 0.f, 0.f, 0.f}; const bf16_t* wr_ = WuqT + (size_t)((hh * 6 + nt) * 16 + m) * 192 + quad * 8;
#pragma unroll
                for (int ks = 0; ks < 6; ++ks) acc[nt] = MFMA16(*(const bf16x8*)(wr_ + ks * 32), aq[ks], acc[nt]); }
#pragma unroll
            for (int j = 0; j < 4; ++j) { const float c = cs4[j >> 1][2 * (j & 1)], sn = cs4[j >> 1][2 * (j & 1) + 1]; const float x1 = acc[4][j], x2 = acc[5][j]; acc[4][j] = x1 * c - x2 * sn; acc[5][j] = x2 * c + x1 * sn; }
            bf16_t* qo = QC + (size_t)tok * 384 + hh * 96 + quad * 4;
#pragma unroll
            for (int nt = 0; nt < 6; ++nt) { u32x2 w; w.x = cvt_pk_bf16(acc[nt][0] * qs, acc[nt][1] * qs); w.y = cvt_pk_bf16(acc[nt][2] * qs, acc[nt][3] * qs); *(u32x2*)(qo + nt * 16) = w; } }
        {   f32x4 acc[8];
#pragma unroll
            for (int nt = 0; nt < 8; ++nt) { acc[nt] = (f32x4){0.f, 0.f, 0.f, 0.f}; const bf16_t* wr_ = WukvT + (size_t)((hh * 8 + nt) * 16 + m) * 128 + quad * 8;
#pragma unroll
                for (int ks = 0; ks < 4; ++ks) acc[nt] = MFMA16(*(const bf16x8*)(wr_ + ks * 32), ak[ks], acc[nt]); }
            bf16_t* ko = KC + (size_t)tok * 384 + hh * 96 + quad * 4; bf16_t* vo = VC + (size_t)tok * 256 + hh * 64 + quad * 4;
#pragma unroll
            for (int nt = 0; nt < 4; ++nt) { u32x2 w; w.x = cvt_pk_bf16(acc[nt][0], acc[nt][1]); w.y = cvt_pk_bf16(acc[nt][2], acc[nt][3]); *(u32x2*)(ko + nt * 16) = w;
                u32x2 w2; w2.x = cvt_pk_bf16(acc[nt + 4][0], acc[nt + 4][1]); w2.y = cvt_pk_bf16(acc[nt + 4][2], acc[nt + 4][3]); *(u32x2*)(vo + nt * 16) = w2; } }
    }
}
__device__ __forceinline__ void pp_mla_lds(int tok0, int hh, const bf16_t* PROJ, bf16_t* QC, bf16_t* KC, bf16_t* VC, const float2* rope, const char* Lq, const char* Lkv, const float* cqn, const float* ckvn, int lane) {
    const int m = lane & 15, quad = lane >> 4, tok = tok0 + m, pos = tok & (SEQ - 1);
    const bf16_t* crow_ = PROJ + (size_t)tok * PPITCH + PC;
    bf16x8 aq[6], ak[4]; float ssq_ = 0.f, ssk_ = 0.f;
#pragma unroll
    for (int ks = 0; ks < 6; ++ks) aq[ks] = *(const bf16x8*)(crow_ + ks * 32 + quad * 8);
#pragma unroll
    for (int ks = 0; ks < 4; ++ks) ak[ks] = *(const bf16x8*)(crow_ + 192 + ks * 32 + quad * 8);
#pragma unroll
    for (int ks = 0; ks < 6; ++ks)
#pragma unroll
        for (int e = 0; e < 8; ++e) { const float x = bf2f((bf16_t)aq[ks][e]); ssq_ += x * x; }
#pragma unroll
    for (int ks = 0; ks < 4; ++ks)
#pragma unroll
        for (int e = 0; e < 8; ++e) { const float x = bf2f((bf16_t)ak[ks][e]); ssk_ += x * x; }
    ssq_ += __shfl_xor(ssq_, 16); ssq_ += __shfl_xor(ssq_, 32); ssk_ += __shfl_xor(ssk_, 16); ssk_ += __shfl_xor(ssk_, 32);
    const float rq = 1.0f / sqrtf(ssq_ * (1.f / 192.f) + EPS), rk = 1.0f / sqrtf(ssk_ * (1.f / 128.f) + EPS);
#pragma unroll
    for (int ks = 0; ks < 6; ++ks) { u32x4 w; const f32x4 ga = *(const f32x4*)(cqn + ks * 32 + quad * 8), gb = *(const f32x4*)(cqn + ks * 32 + quad * 8 + 4);
#pragma unroll
        for (int e = 0; e < 4; ++e) { const float g0 = e < 2 ? ga[2 * e] : gb[2 * e - 4], g1 = e < 2 ? ga[2 * e + 1] : gb[2 * e - 3]; w[e] = cvt_pk_bf16(bf2f((bf16_t)aq[ks][2 * e]) * rq * g0, bf2f((bf16_t)aq[ks][2 * e + 1]) * rq * g1); }
        aq[ks] = __builtin_bit_cast(bf16x8, w); }
#pragma unroll
    for (int ks = 0; ks < 4; ++ks) { u32x4 w; const f32x4 ga = *(const f32x4*)(ckvn + ks * 32 + quad * 8), gb = *(const f32x4*)(ckvn + ks * 32 + quad * 8 + 4);
#pragma unroll
        for (int e = 0; e < 4; ++e) { const float g0 = e < 2 ? ga[2 * e] : gb[2 * e - 4], g1 = e < 2 ? ga[2 * e + 1] : gb[2 * e - 3]; w[e] = cvt_pk_bf16(bf2f((bf16_t)ak[ks][2 * e]) * rk * g0, bf2f((bf16_t)ak[ks][2 * e + 1]) * rk * g1); }
        ak[ks] = __builtin_bit_cast(bf16x8, w); }
    const float qs = 0.10206207261596577f * LOG2E;
    f32x4 cs4[2];
#pragma unroll
    for (int q = 0; q < 2; ++q) cs4[q] = *(const f32x4*)(rope + pos * 16 + quad * 4 + 2 * q);
    {
        {   f32x4 acc[6];
#pragma unroll
            for (int nt = 0; nt < 6; ++nt) { acc[nt] = (f32x4){0.f, 0.f, 0.f, 0.f}; const char* wr_ = Lq + (nt * 16 + m) * 400 + quad * 16;
#pragma unroll
                for (int ks = 0; ks < 6; ++ks) acc[nt] = MFMA16(*(const bf16x8*)(wr_ + ks * 64), aq[ks], acc[nt]); }
#pragma unroll
            for (int j = 0; j < 4; ++j) { const float c = cs4[j >> 1][2 * (j & 1)], sn = cs4[j >> 1][2 * (j & 1) + 1]; const float x1 = acc[4][j], x2 = acc[5][j]; acc[4][j] = x1 * c - x2 * sn; acc[5][j] = x2 * c + x1 * sn; }
            bf16_t* qo = QC + (size_t)tok * 384 + hh * 96 + quad * 4;
#pragma unroll
            for (int nt = 0; nt < 6; ++nt) { u32x2 w; w.x = cvt_pk_bf16(acc[nt][0] * qs, acc[nt][1] * qs); w.y = cvt_pk_bf16(acc[nt][2] * qs, acc[nt][3] * qs); *(u32x2*)(qo + nt * 16) = w; } }
        {   f32x4 acc[8];
#pragma unroll
            for (int nt = 0; nt < 8; ++nt) { acc[nt] = (f32x4){0.f, 0.f, 0.f, 0.f}; const char* wr_ = Lkv + (nt * 16 + m) * 288 + quad * 16;
#pragma unroll
                for (int ks = 0; ks < 4; ++ks) acc[nt] = MFMA16(*(const bf16x8*)(wr_ + ks * 64), ak[ks], acc[nt]); }
            bf16_t* ko = KC + (size_t)tok * 384 + hh * 96 + quad * 4; bf16_t* vo = VC + (size_t)tok * 256 + hh * 64 + quad * 4;
#pragma unroll
            for (int nt = 0; nt < 4; ++nt) { u32x2 w; w.x = cvt_pk_bf16(acc[nt][0], acc[nt][1]); w.y = cvt_pk_bf16(acc[nt][2], acc[nt][3]); *(u32x2*)(ko + nt * 16) = w;
                u32x2 w2; w2.x = cvt_pk_bf16(acc[nt + 4][0], acc[nt + 4][1]); w2.y = cvt_pk_bf16(acc[nt + 4][2], acc[nt + 4][3]); *(u32x2*)(vo + nt * 16) = w2; } }
    }
}

template <int DQK, int NSUB, int MODE>
__device__ __forceinline__ void flash_unit(LAS char* L, const bf16_t* Qp, int qpitch, const bf16_t* Kp, int kpitch, const bf16_t* Vp, int vpitch,
                                           bf16_t* Op, int opitch, float lam, float oscale, const float* subln) {
    constexpr int KW = NSUB * DQK, KPB = KW * 2 + 16, VPB = 144, KBUF = 64 * KPB, VBUF = 64 * VPB, KCH = KW / 8, NKCH = 64 * KCH, ND0 = DQK / 16;
    constexpr int OFF_V = 2 * KBUF;
    const int tid = otid(), lane = tid & 63, wid = tid >> 6, r32 = lane & 31, hi = lane >> 5;
    char* Lg = (char*)L;
    bf16x8 qf[NSUB][ND0];
    { const bf16_t* qrow = Qp + (size_t)(32 * wid + r32) * qpitch;
#pragma unroll
      for (int s = 0; s < NSUB; ++s)
#pragma unroll
          for (int d0 = 0; d0 < ND0; ++d0) qf[s][d0] = *(const bf16x8*)(qrow + s * DQK + 16 * d0 + 8 * hi); }
    const int kr1 = tid / KCH, kc1 = tid % KCH, kr2 = (tid + 512) / KCH, kc2 = (tid + 512) % KCH; const bool has2 = (tid + 512) < NKCH;
    const int vr1 = tid >> 3, vc1 = tid & 7;
    const bf16_t* kg1 = Kp + (size_t)kr1 * kpitch + kc1 * 8; const bf16_t* kg2 = Kp + (size_t)kr2 * kpitch + kc2 * 8; const bf16_t* vg1 = Vp + (size_t)vr1 * vpitch + vc1 * 8;
    const int kl1 = kr1 * KPB + kc1 * 16, kl2 = kr2 * KPB + kc2 * 16, vl1 = vr1 * VPB + vc1 * 16;
    u32x4 rk1, rk2 = {0u, 0u, 0u, 0u}, rv1;
    float mref[NSUB], lrow[NSUB]; f32x16 o[NSUB][2], negm[NSUB];
#pragma unroll
    for (int s = 0; s < NSUB; ++s) { mref[s] = 0.f; lrow[s] = 0.f;
#pragma unroll
        for (int r = 0; r < 16; ++r) { o[s][0][r] = 0.f; o[s][1][r] = 0.f; negm[s][r] = 0.f; } }
    __syncthreads();
    rk1 = *(const u32x4*)kg1; if (has2) rk2 = *(const u32x4*)kg2; rv1 = *(const u32x4*)vg1;
    *(u32x4*)(Lg + kl1) = rk1; if (has2) *(u32x4*)(Lg + kl2) = rk2; *(u32x4*)(Lg + OFF_V + vl1) = rv1;
    __syncthreads();
    const int vq = (lane & 15) >> 2, vp_ = lane & 3, vblk = (lane >> 4) & 1;
    const int voff = (4 * hi + vq) * VPB + (16 * vblk + 4 * vp_) * 2;
    if (__builtin_amdgcn_readfirstlane(wid) >= 4) __builtin_amdgcn_s_setprio(1);
    for (int t = 0; t < SEQ / 64; ++t) {
        const int buf = t & 1;
        if (t + 1 < SEQ / 64) { const size_t ko = (size_t)(t + 1) * 64 * kpitch, vo = (size_t)(t + 1) * 64 * vpitch;
            rk1 = *(const u32x4*)(kg1 + ko); if (has2) rk2 = *(const u32x4*)(kg2 + ko); rv1 = *(const u32x4*)(vg1 + vo); }
        const char* Kb = Lg + buf * KBUF; LAS const char* Vb = L + OFF_V + buf * VBUF + voff;
#pragma unroll
        for (int s = 0; s < NSUB; ++s) {
            f32x16 p0, p1;
#pragma unroll
            for (int d0 = 0; d0 < ND0; ++d0) { const bf16x8 k0 = *(const bf16x8*)(Kb + r32 * KPB + (s * DQK + 16 * d0 + 8 * hi) * 2); const bf16x8 k1 = *(const bf16x8*)(Kb + (32 + r32) * KPB + (s * DQK + 16 * d0 + 8 * hi) * 2);
                if (d0 == 0) { p0 = MFMA32(k0, qf[s][d0], negm[s]); p1 = MFMA32(k1, qf[s][d0], negm[s]); }
                else { p0 = MFMA32(k0, qf[s][d0], p0); p1 = MFMA32(k1, qf[s][d0], p1); } }
#pragma unroll
            for (int hf = 0; hf < 2; ++hf) {
                f32x16& ph = hf ? p1 : p0;
                float mx = fmaxf(ph[0], ph[1]);
#pragma unroll
                for (int r = 2; r < 16; ++r) mx = fmaxf(mx, ph[r]);
                mx = fmaxf(mx, __shfl_xor(mx, 32));
                const bool first = (t == 0) && (hf == 0);
                if (first || __any(mx > 8.0f)) {
                    const float dl = first ? mx : fmaxf(mx, 0.f); mref[s] += dl;
#pragma unroll
                    for (int r = 0; r < 16; ++r) { ph[r] -= dl; negm[s][r] = -mref[s]; }
                    if (hf == 0) {
#pragma unroll
                        for (int r = 0; r < 16; ++r) p1[r] -= dl;
                    }
                    if (!first) { const float alpha = __builtin_amdgcn_exp2f(-dl); lrow[s] *= alpha;
#pragma unroll
                        for (int r = 0; r < 16; ++r) { o[s][0][r] *= alpha; o[s][1][r] *= alpha; } }
                }
#pragma unroll
                for (int r = 0; r < 16; ++r) ph[r] = __builtin_amdgcn_exp2f(ph[r]);
                { typedef float f32x2_ __attribute__((ext_vector_type(2))); f32x2_ r2 = {ph[0], ph[1]};
#pragma unroll
                  for (int r = 2; r < 16; r += 2) r2 += (f32x2_){ph[r], ph[r + 1]};
                  lrow[s] += r2[0] + r2[1]; }
                bf16x8 pf[2];
#pragma unroll
                for (int k2 = 0; k2 < 2; ++k2) { u32x4 w;
#pragma unroll
                    for (int e = 0; e < 4; ++e) w[e] = cvt_pk_bf16(ph[8 * k2 + 2 * e], ph[8 * k2 + 2 * e + 1]);
                    pf[k2] = __builtin_bit_cast(bf16x8, w); }
#pragma unroll
                for (int db = 0; db < 2; ++db)
#pragma unroll
                    for (int k2 = 0; k2 < 2; ++k2) { const int ks = 2 * hf + k2; const v4i16_t lo = vtr(Vb + (16 * ks) * VPB + db * 64), hh = vtr(Vb + (16 * ks + 8) * VPB + db * 64);
                        const bf16x8 vf = {lo[0], lo[1], lo[2], lo[3], hh[0], hh[1], hh[2], hh[3]};
                        o[s][db] = MFMA32(vf, pf[k2], o[s][db]); }
            }
        }
        if (t + 1 < SEQ / 64) { char* Kn = Lg + (buf ^ 1) * KBUF; *(u32x4*)(Kn + kl1) = rk1; if (has2) *(u32x4*)(Kn + kl2) = rk2; *(u32x4*)(Lg + OFF_V + (buf ^ 1) * VBUF + vl1) = rv1; }
        __syncthreads();
    }
    __builtin_amdgcn_s_setprio(0);
    bf16_t* orow = Op + (size_t)(32 * wid + r32) * opitch;
    if (MODE == 0) {
        const float inv = 1.0f / (lrow[0] + __shfl_xor(lrow[0], 32));
#pragma unroll
        for (int db = 0; db < 2; ++db)
#pragma unroll
            for (int g = 0; g < 4; ++g) { u32x2 w; w.x = cvt_pk_bf16(o[0][db][4 * g] * inv, o[0][db][4 * g + 1] * inv); w.y = cvt_pk_bf16(o[0][db][4 * g + 2] * inv, o[0][db][4 * g + 3] * inv);
                *(u32x2*)(orow + 32 * db + 8 * g + 4 * hi) = w; }
    } else {
        const float i1 = 1.0f / (lrow[0] + __shfl_xor(lrow[0], 32)), i2 = lam / (lrow[NSUB - 1] + __shfl_xor(lrow[NSUB - 1], 32));
        float ss = 0.f;
#pragma unroll
        for (int db = 0; db < 2; ++db)
#pragma unroll
            for (int r = 0; r < 16; ++r) { const float v = o[0][db][r] * i1 - o[NSUB - 1][db][r] * i2; o[0][db][r] = v; ss += v * v; }
        ss += __shfl_xor(ss, 32);
        const float rn = oscale / sqrtf(ss * (1.f / 64.f) + EPS);
#pragma unroll
        for (int db = 0; db < 2; ++db)
#pragma unroll
            for (int g = 0; g < 4; ++g) { const int d = 32 * db + 8 * g + 4 * hi; const f32x4 sg = *(const f32x4*)(subln + d);
                u32x2 w; w.x = cvt_pk_bf16(o[0][db][4 * g] * rn * sg[0], o[0][db][4 * g + 1] * rn * sg[1]); w.y = cvt_pk_bf16(o[0][db][4 * g + 2] * rn * sg[2], o[0][db][4 * g + 3] * rn * sg[3]);
                *(u32x2*)(orow + d) = w; }
    }
}

__device__ __forceinline__ void natten_unit(LAS char* L, const bf16_t* Pseq  , bf16_t* Oseq  , int h, int r0, const float* rpb) {
    constexpr int VPB = 144, OFF_RPB = 11 * 64 * VPB;
    const int tid = otid(), lane = tid & 63, wid = tid >> 6, m = lane & 15, quad = lane >> 4;
    char* Lg = (char*)L; float* rpbL = (float*)(Lg + OFF_RPB);
    int rs_lo = r0 - 4; rs_lo = rs_lo < 0 ? 0 : (rs_lo > 24 ? 24 : rs_lo);
    int rs_hi = r0 + 3 - 4; rs_hi = rs_hi < 0 ? 0 : (rs_hi > 24 ? 24 : rs_hi);
    const int nst = (rs_hi - rs_lo + 8) * 64 * 8;
    __syncthreads();
    {   const bf16_t* vsrc = Pseq + (size_t)(rs_lo * 64) * PPITCH + PB + 512 + h * 64;
#pragma unroll
        for (int i = 0; i < 11; ++i) { const int c = tid + 512 * i; if (c < nst) { const int row = c >> 3, ch = c & 7; *(u32x4*)(Lg + row * VPB + ch * 16) = *(const u32x4*)(vsrc + (size_t)row * PPITCH + ch * 8); } }
        if (tid < 465) rpbL[tid] = rpb[h * 465 + tid] * LOG2E;
    }
    __syncthreads();
#pragma unroll 1
    for (int it = 0; it < 2; ++it) {
        const int item = wid + 8 * it, r = r0 + (item >> 2), n = item & 3;
        int rs = r - 4; rs = rs < 0 ? 0 : (rs > 24 ? 24 : rs);
        int cb = 16 * n - 8; cb = cb < 0 ? 0 : (cb > 32 ? 32 : cb);
        const int qcol = 16 * n + m; int cs = qcol - 8; cs = cs < 0 ? 0 : (cs > 48 ? 48 : cs);
        const bf16_t* qrow = Pseq + (size_t)(r * 64 + qcol) * PPITCH + PB + h * 64 + quad * 8;
        const bf16x8 qf0 = *(const bf16x8*)qrow, qf1 = *(const bf16x8*)(qrow + 32);
        f32x4 sc[16];
#pragma unroll
        for (int t = 0; t < 16; ++t) { const int kr = t >> 1, kc0 = (t & 1) * 16;
            const bf16_t* krow = Pseq + (size_t)((rs + kr) * 64 + cb + kc0 + m) * PPITCH + PB + 256 + h * 64 + quad * 8;
            const bf16x8 k0 = *(const bf16x8*)krow, k1 = *(const bf16x8*)(krow + 32);
            f32x4 a = {0.f, 0.f, 0.f, 0.f}; a = MFMA16(k0, qf0, a); a = MFMA16(k1, qf1, a);
            const int dr = rs + kr - r + 7;
#pragma unroll
            for (int j = 0; j < 4; ++j) { const int kcol = cb + kc0 + 4 * quad + j; const bool ok = (kcol >= cs) && (kcol < cs + 16); int dc = kcol - qcol + 15; dc = dc < 0 ? 0 : (dc > 30 ? 30 : dc);
                a[j] = ok ? a[j] + rpbL[dr * 31 + dc] : -INFINITY; }
            sc[t] = a; }
        float mx = -INFINITY;
#pragma unroll
        for (int t = 0; t < 16; ++t) mx = fmaxf(mx, fmaxf(fmaxf(sc[t][0], sc[t][1]), fmaxf(sc[t][2], sc[t][3])));
        mx = fmaxf(mx, __shfl_xor(mx, 16)); mx = fmaxf(mx, __shfl_xor(mx, 32));
        float sum = 0.f;
#pragma unroll
        for (int t = 0; t < 16; ++t)
#pragma unroll
            for (int j = 0; j < 4; ++j) { const float e = __builtin_amdgcn_exp2f(sc[t][j] - mx); sc[t][j] = e; sum += e; }
        sum += __shfl_xor(sum, 16); sum += __shfl_xor(sum, 32);
        const float inv = 1.0f / sum;
        f32x4 o[4];
#pragma unroll
        for (int dt = 0; dt < 4; ++dt) o[dt] = (f32x4){0.f, 0.f, 0.f, 0.f};
        LAS const char* Vb = L + (size_t)((rs - rs_lo) * 64 + cb + 4 * quad + (m >> 2)) * VPB + (lane & 3) * 8;
#pragma unroll
        for (int u = 0; u < 8; ++u) { u32x4 w; w.x = cvt_pk_bf16(sc[2 * u][0], sc[2 * u][1]); w.y = cvt_pk_bf16(sc[2 * u][2], sc[2 * u][3]);
            w.z = cvt_pk_bf16(sc[2 * u + 1][0], sc[2 * u + 1][1]); w.w = cvt_pk_bf16(sc[2 * u + 1][2], sc[2 * u + 1][3]);
            const bf16x8 pf = __builtin_bit_cast(bf16x8, w);
#pragma unroll
            for (int dt = 0; dt < 4; ++dt) { const v4i16_t lo = vtr(Vb + (u * 64) * VPB + dt * 32), hh = vtr(Vb + (u * 64 + 16) * VPB + dt * 32);
                const bf16x8 vf = {lo[0], lo[1], lo[2], lo[3], hh[0], hh[1], hh[2], hh[3]};
                o[dt] = MFMA16(vf, pf, o[dt]); } }
        bf16_t* orow = Oseq + (size_t)(r * 64 + qcol) * 256 + h * 64 + 4 * quad;
#pragma unroll
        for (int dt = 0; dt < 4; ++dt) { u32x2 w; w.x = cvt_pk_bf16(o[dt][0] * inv, o[dt][1] * inv); w.y = cvt_pk_bf16(o[dt][2] * inv, o[dt][3] * inv); *(u32x2*)(orow + dt * 16) = w; }
    }
}

#define XB_TMO      128
#define XB_XCNT(j)  (256  + 64 * (j))
#define XB_XSUB(j)  (1280 + 64 * (j))
#define XB_XGEN(j)  (2304 + 64 * (j))
#define XB_TOP      3328
#define XB_TOPGEN   3392
#define XCD_BAR_WORDS 3456
#define XB_SPIN_CAP (1u << 18)

__device__ __forceinline__ unsigned xb_ld(unsigned* p)              { return __hip_atomic_load(p, __ATOMIC_RELAXED, __HIP_MEMORY_SCOPE_AGENT); }
__device__ __forceinline__ unsigned xb_add(unsigned* p, unsigned v) { return __hip_atomic_fetch_add(p, v, __ATOMIC_RELAXED, __HIP_MEMORY_SCOPE_AGENT); }
__device__ __forceinline__ unsigned xb_xcc_id() { return (unsigned)__builtin_amdgcn_s_getreg((3 << 11) | 20) & 0xFu; }
#define XB_SPIN(cond, bar) do { unsigned _sp = 0; while (cond) { __builtin_amdgcn_s_sleep(1); \
    if ((++_sp & 255u) == 0u) { if (xb_ld(&(bar)[XB_TMO])) break; if (_sp > XB_SPIN_CAP) { atomicAdd(&(bar)[XB_TMO], 1u); break; } } } } while (0)

struct XcdBarrier {
    unsigned* bar; unsigned x;
    volatile LAS unsigned* st;
};

__device__ __forceinline__ XcdBarrier xcd_barrier_post(unsigned* bar, volatile LAS unsigned* st) {
    XcdBarrier b; b.bar = bar; b.x = xb_xcc_id(); b.st = st;
    if (threadIdx.x == 0) (void)xb_add(&bar[XB_XCNT(b.x)], 1u);
    return b;
}
__device__ __forceinline__ void xcd_barrier_complete(unsigned* bar, unsigned x, unsigned& nloc, unsigned& nx) {
    const unsigned G = gridDim.x * gridDim.y * gridDim.z;
    unsigned sum, cnt, mine, sp = 0u;
    for (;;) {
        sum = 0u; cnt = 0u; mine = 0u;
#pragma unroll
        for (unsigned j = 0; j < 16; ++j) { const unsigned c = xb_ld(&bar[XB_XCNT(j)]); sum += c; cnt += (c > 0u) ? 1u : 0u; mine = (j == x) ? c : mine; }
        if (sum == G) break;
        __builtin_amdgcn_s_sleep(1);
        if ((++sp & 255u) == 0u) { if (xb_ld(&bar[XB_TMO])) break; if (sp > XB_SPIN_CAP) { atomicAdd(&bar[XB_TMO], 1u); break; } }
    }
    nloc = mine > 0u ? mine : 1u; nx = cnt > 0u ? cnt : 1u;
}

__device__ __forceinline__ void xcd_barrier(const XcdBarrier& b) {
    asm volatile("s_waitcnt vmcnt(0)" ::: "memory");
    __syncthreads();
    if (threadIdx.x == 0) {
        unsigned* bar = b.bar;
        __builtin_amdgcn_s_waitcnt(0);
        unsigned nloc = b.st[0], nx = b.st[1];
        if (nloc == 0u) { xcd_barrier_complete(bar, b.x, nloc, nx); b.st[0] = nloc; b.st[1] = nx; }
        const unsigned old = xb_add(&bar[XB_XSUB(b.x)], 1u);
        const unsigned gen = old / nloc;
        if (old + 1u == (gen + 1u) * nloc) {
            __builtin_amdgcn_fence(__ATOMIC_RELEASE, "agent");
            asm volatile("s_waitcnt vmcnt(0)" ::: "memory");
            const unsigned og = xb_add(&bar[XB_TOP], 1u);
            const unsigned tg = og / nx;
            if (og + 1u == (tg + 1u) * nx) xb_add(&bar[XB_TOPGEN], 1u);
            else XB_SPIN(xb_ld(&bar[XB_TOPGEN]) == tg, bar);
            __builtin_amdgcn_fence(__ATOMIC_ACQUIRE, "agent");
            xb_add(&bar[XB_XGEN(b.x)], 1u);
            asm volatile("s_waitcnt vmcnt(0)" ::: "memory");
        } else {
            XB_SPIN(xb_ld(&bar[XB_XGEN(b.x)]) == gen, bar);
            __builtin_amdgcn_fence(__ATOMIC_ACQUIRE, "agent");
            asm volatile("s_waitcnt vmcnt(0)" ::: "memory");
        }
    }
    __syncthreads();
}

__global__ void __launch_bounds__(NTHR, 2) mega_fwd(Args a) {
    extern __shared__ __attribute__((aligned(16))) unsigned char lds_raw[];
    cg::grid_group grid = cg::this_grid();
    LAS unsigned char* lds = (LAS unsigned char*)lds_raw;
    const int G = gridDim.x, bx = blockIdx.x;
    const int vcu = (G % 8 == 0) ? (bx % 8) * (G / 8) + bx / 8 : bx;
    const int NGW = G * NWAVES, NT = G * NTHR;
#define TIDS() const int tid = otid(), lane = tid & 63, wave = __builtin_amdgcn_readfirstlane(tid >> 6), gw = vcu * NWAVES + wave, gtid = vcu * NTHR + tid; (void)lane; (void)gw; (void)gtid
#define WSP(name) unsigned char* name = a.ws; asm volatile("" : "+s"(name))

    volatile LAS unsigned* MISC = (volatile LAS unsigned*)(lds + 133120);
    if (otid() < 32) MISC[otid()] = 0u;
    __syncthreads();
    XcdBarrier bar = xcd_barrier_post((unsigned*)a.ws, MISC + 8);
#define GSYNC() xcd_barrier(bar)
    PH(0) { WSP(w); TIDS(); prologue(a, w, (char*)lds_raw, gw, NGW, wave, lane); }
    grid.sync();

#pragma unroll 1
    for (int g = 0; g < NGROUP; ++g) {
#pragma unroll 1
        for (int l = 0; l < DEPTH; ++l) {
            int row_g0 = g * TMAX, T = (g < 2) ? TMAX : (NTOK - 2 * TMAX); asm volatile("" : "+s"(row_g0), "+s"(T));
            if (l == 0) {
                PH(1) { WSP(w); TIDS(); convert_phase(a.in[0], a.in[1], row_g0, T, (bf16_t*)(w + WS_XN), (float*)(w + WS_MRG), gw, NGW, lane); }
                GSYNC();
            }
            PH(2) { WSP(w); pg8::Gemm gm{(const bf16_t*)(w + WS_XN), (const bf16_t*)(w + WS_WIN) + (size_t)l * NPROJ * DM, T, NPROJ, DM}; pg8::StaticOrder S; S.init(T, NPROJ, G, bx); pg8::EpiProj E{(bf16_t*)(w + WS_PROJ), PPITCH, PG / 256, (const float*)(w + WS_MRG), (bf16_t*)(w + WS_RAT), T};
              pg8::gemm_phase<pg8::EpiProj, pg8::StaticOrder, true, true>(lds, gm, S, E); }
            GSYNC();
            PH(3) { WSP(w); TIDS(); bf16_t* PROJ = (bf16_t*)(w + WS_PROJ);
                bf16_t* KC = (bf16_t*)(w + WS_KC); const float2* rope = (const float2*)(w + WS_ROPE);
#pragma unroll 1
                for (int t0 = gw; t0 < T; t0 += 2 * NGW) { if (t0 + NGW < T) { const int tk[2] = {t0, t0 + NGW}; pp_elem<2>(tk, PROJ, KC, rope, a.in[14] + l * 64, a.in[15] + l * 64, lane); }
                                                          else { const int tk[1] = {t0}; pp_elem<1>(tk, PROJ, KC, rope, a.in[14] + l * 64, a.in[15] + l * 64, lane); } }
                }
#pragma unroll 1
                for (int hh = 0; hh < 4; ++hh) { WSP(w2); TIDS(); char* Lw = (char*)lds_raw;
                    const bf16_t* Wq_ = (const bf16_t*)(w2 + WS_WUQ) + (size_t)l * 384 * 192 + (size_t)hh * 96 * 192; const bf16_t* Wkv_ = (const bf16_t*)(w2 + WS_WUKV) + (size_t)l * 512 * 128 + (size_t)hh * 128 * 128;
                    __syncthreads();
#pragma unroll
                    for (int i_ = 0; i_ < 9; ++i_) { const int c = tid + 512 * i_;
                        if (c < 2304) { const int row = c / 24, ch = c - row * 24; *(u32x4*)(Lw + row * 400 + ch * 16) = *(const u32x4*)(Wq_ + row * 192 + ch * 8); }
                        else if (c < 4352) { const int c2 = c - 2304, row = c2 >> 4, ch = c2 & 15; *(u32x4*)(Lw + 38400 + row * 288 + ch * 16) = *(const u32x4*)(Wkv_ + row * 128 + ch * 8); } }
                    __syncthreads();
#pragma unroll 1
                    for (int tl = wave * G + vcu; tl < T / 16; tl += NGW) pp_mla_lds(tl * 16, hh, (const bf16_t*)(w2 + WS_PROJ), (bf16_t*)(w2 + WS_QC), (bf16_t*)(w2 + WS_KC), (bf16_t*)(w2 + WS_VC), (const float2*)(w2 + WS_ROPE), Lw, Lw + 38400, a.in[10] + l * 192, a.in[11] + l * 128, lane);
                }
            GSYNC();
            PH(4) {
                const float lam_init = (l == 0) ? 0.2f : (0.8f - 0.6f * 0.7408182206817179f);
                const int NU_F = (T >> 11) * 4 * 8, NU_B = (T >> 11) * 4 * 8;
                if (FLK & 1) {
                    float s1 = 0.f, s2 = 0.f;
                    for (int i = 0; i < 32; ++i) { s1 += a.in[4][l * 32 + i] * a.in[5][l * 32 + i]; s2 += a.in[6][l * 32 + i] * a.in[7][l * 32 + i]; }
                    const float lam = expf(s1) - expf(s2) + lam_init;
#pragma unroll 1
                    for (int uu = vcu; uu < NU_F; uu += G) { WSP(w); bf16_t* PROJ = (bf16_t*)(w + WS_PROJ); bf16_t* OB = (bf16_t*)(w + WS_OB);
                        const int b = uu >> 5, h = (uu >> 3) & 3, qb = uu & 7; const size_t sb = (size_t)b * SEQ, q0 = sb + (size_t)qb * 256;
                        flash_unit<32, 2, 1>((LAS char*)lds, PROJ + q0 * PPITCH + PA + h * 64, PPITCH, PROJ + sb * PPITCH + PA + 256 + h * 64, PPITCH, PROJ + sb * PPITCH + PA + 512 + h * 64, PPITCH,
                                             OB + q0 * 256 + h * 64, 256, lam, 1.0f - lam_init, a.in[8] + l * 64); } }
                if (FLK & 2) {
#pragma unroll 1
                    for (int uu = vcu; uu < NU_F; uu += G) { WSP(w); bf16_t* QC = (bf16_t*)(w + WS_QC); bf16_t* KC = (bf16_t*)(w + WS_KC); bf16_t* VC = (bf16_t*)(w + WS_VC); bf16_t* OB = (bf16_t*)(w + WS_OB);
                        const int b = uu >> 5, h = (uu >> 3) & 3, qb = uu & 7; const size_t sb = (size_t)b * SEQ, q0 = sb + (size_t)qb * 256;
                        flash_unit<96, 1, 0>((LAS char*)lds, QC + q0 * 384 + h * 96, 384, KC + sb * 384 + h * 96, 384, VC + sb * 256 + h * 64, 256,
                                             OB + (size_t)2 * T * 256 + q0 * 256 + h * 64, 256, 0.f, 1.f, nullptr); } }
                if (FLK & 4) {
#pragma unroll 1
                    for (int uu = vcu; uu < NU_F; uu += G) { WSP(w); bf16_t* PROJ = (bf16_t*)(w + WS_PROJ); bf16_t* OB = (bf16_t*)(w + WS_OB);
                        const int b = uu >> 5, h = (uu >> 3) & 3, qb = uu & 7; const size_t sb = (size_t)b * SEQ, q0 = sb + (size_t)qb * 256;
                        flash_unit<64, 1, 0>((LAS char*)lds, PROJ + q0 * PPITCH + PD + h * 64, PPITCH, PROJ + sb * PPITCH + PD + 256 + (h >> 1) * 64, PPITCH, PROJ + sb * PPITCH + PD + 384 + (h >> 1) * 64, PPITCH,
                                             OB + (size_t)3 * T * 256 + q0 * 256 + h * 64, 256, 0.f, 1.f, nullptr); } }
                if (FLK & 8) {
#pragma unroll 1
                    for (int uu = vcu; uu < NU_B; uu += G) { WSP(w); bf16_t* PROJ = (bf16_t*)(w + WS_PROJ); bf16_t* OB = (bf16_t*)(w + WS_OB);
                        const int b = uu >> 5, h = (uu >> 3) & 3, r0 = (uu & 7) * 4;
                        natten_unit((LAS char*)lds, PROJ + (size_t)b * SEQ * PPITCH, OB + (size_t)1 * T * 256 + (size_t)b * SEQ * 256, h, r0, a.in[9] + l * 4 * 465); } }
            }
            GSYNC();
            PH(5) { WSP(w); pg8::Gemm gm{(const bf16_t*)(w + WS_OB), (const bf16_t*)(w + WS_WBR) + (size_t)l * 4 * 1024 * 256, 4 * T, 4096, 256}; pg8::BranchOrder S{T / 256, G, bx};
              pg8::EpiBranch E{(const bf16_t*)(w + WS_RAT), T, (bf16_t*)(w + WS_MB), T / 256};
              pg8::gemm_phase<pg8::EpiBranch, pg8::BranchOrder, true, true>(lds, gm, S, E); }
            GSYNC();
            PH(6) { WSP(w); pg8::Gemm gm{(const bf16_t*)(w + WS_MB), (const bf16_t*)(w + WS_WOUT) + (size_t)l * DM * DM, T, DM, DM}; asm volatile("" : "+s"(gm.A), "+s"(gm.Bt)); pg8::StaticOrder S; S.init(T, DM, G, bx);
              pg8::EpiResid E{(bf16_t*)(w + WS_XN), (float*)(w + WS_MRG) + 16 * TMAX};
              pg8::gemm_phase<pg8::EpiResid, pg8::StaticOrder, true, true>(lds, gm, S, E); }
            GSYNC();
            PH(8) { WSP(w); pg8::Gemm gm{(const bf16_t*)(w + WS_XN), (const bf16_t*)(w + WS_WFI) + (size_t)l * NUG * DM, T, NUG, DM}; asm volatile("" : "+s"(gm.A), "+s"(gm.Bt)); pg8::StaticOrder S; S.init(T, NUG, G, bx);
              pg8::EpiFfn E{(bf16_t*)(w + WS_ACT), (float*)(w + WS_MRG) + 64 * TMAX, (const float*)(w + WS_MRG) + 16 * TMAX, a.in[20] + (size_t)l * 3 * FF, a.in[21] + (size_t)l * FF, T / 64};
              pg8::gemm_phase<pg8::EpiFfn, pg8::StaticOrder, true, true>(lds, gm, S, E); }
            GSYNC();
            PH(9) { WSP(w); TIDS(); conv_fix_phase((const float*)(w + WS_MRG) + 64 * TMAX, (bf16_t*)(w + WS_ACT), a.in[20] + (size_t)l * 3 * FF, T, gtid, NT); }
            GSYNC();
            PH(10) { WSP(w); pg8::Gemm gm{(const bf16_t*)(w + WS_ACT), (const bf16_t*)(w + WS_WFO) + (size_t)l * DM * FF, T, DM, FF}; asm volatile("" : "+s"(gm.A), "+s"(gm.Bt)); pg8::StaticOrder S; S.init(T, DM, G, bx);
              pg8::EpiResid E{(bf16_t*)(w + WS_XN), (float*)(w + WS_MRG)};
              pg8::gemm_phase<pg8::EpiResid, pg8::StaticOrder, true, true>(lds, gm, S, E); }
            GSYNC();
            PH(11) { WSP(w); TIDS(); if (l == DEPTH - 1) final_norm_phase(a.out, row_g0, T, (const bf16_t*)(w + WS_XN), (const float*)(w + WS_MRG), a.in[23], gw, NGW, lane); }
            if (l == DEPTH - 1) GSYNC();
        }
    }
}

extern "C" void kernel_launch(void* const* d_in, const int* in_sizes, int n_in, void* d_out, int out_size, void* d_ws, size_t ws_size, hipStream_t stream) {
    static int grid = 0;
    if (grid == 0) {
        if (n_in != 24 || out_size != NTOK * DM || ws_size < WS_END) { fprintf(stderr, "kernel_launch: unexpected shapes (n_in %d, out %d, ws %zu)\n", n_in, out_size, ws_size); grid = -1; return; }
        int dev = 0, cus = 0, per_cu = 0;
        if (hipGetDevice(&dev) != hipSuccess || hipDeviceGetAttribute(&cus, hipDeviceAttributeMultiprocessorCount, dev) != hipSuccess) { grid = -1; return; }
        if (hipFuncSetAttribute((const void*)mega_fwd, hipFuncAttributeMaxDynamicSharedMemorySize, LDS_BYTES) != hipSuccess) { fprintf(stderr, "kernel_launch: hipFuncSetAttribute failed\n"); grid = -1; return; }
        if (hipOccupancyMaxActiveBlocksPerMultiprocessor(&per_cu, (const void*)mega_fwd, NTHR, LDS_BYTES) != hipSuccess || per_cu < 1) { fprintf(stderr, "kernel_launch: occupancy query says %d\n", per_cu); per_cu = 1; }
        (void)hipGetLastError();
        grid = cus * per_cu;
    }
    if (grid < 0) return;
    if (hipMemsetAsync(d_ws, 0, 16384, stream) != hipSuccess) { fprintf(stderr, "kernel_launch: memset of barrier words failed\n"); return; }
    Args a{};
    for (int i = 0; i < 24; ++i) a.in[i] = (const float*)d_in[i];
    a.out = (float*)d_out; a.ws = (unsigned char*)d_ws;
    void* args[] = {&a};
    hipError_t e = hipLaunchCooperativeKernel((const void*)mega_fwd, dim3(grid), dim3(NTHR), args, LDS_BYTES, stream);
    if (e != hipSuccess) fprintf(stderr, "kernel_launch: cooperative launch failed: %s (grid %d)\n", hipGetErrorString(e), grid);
}
```

```cpp
#include <hip/hip_runtime.h>
#include <hip/hip_cooperative_groups.h>
#include <cstdio>
#include <cstdint>
namespace cg = cooperative_groups;

__device__ __forceinline__ int otid() { int t = threadIdx.x; asm volatile("" : "+v"(t)); return t; }
namespace pg8 {
#define PG8_LAS __attribute__((address_space(3)))
typedef unsigned short bf16_t;
typedef short bf16x8 __attribute__((ext_vector_type(8)));
typedef float f32x4 __attribute__((ext_vector_type(4)));
typedef unsigned u32x4 __attribute__((ext_vector_type(4)));
constexpr int BM = 256, BK = 64, HALF = 128, HTB = HALF * BK * 2  , STAGE_BYTES = 8 * HTB, NXCD = 8, WGM = 8;

__host__ __device__ __forceinline__ int lds_byte(int r, int c) { const int st = (r >> 4) * 2 + (c >> 5), rr = r & 15, cc = c & 31, ob = rr * 64 + cc * 2; return st * 1024 + (ob ^ (((ob >> 9) & 1) << 5)); }
__host__ __device__ __forceinline__ void stage_rc(int b, int& R, int& C) { const int st = b / 1024, sb = b % 1024, swz = sb ^ (((sb >> 9) & 1) << 5); R = (st >> 1) * 16 + swz / 64; C = (st & 1) * 32 + (swz % 64) / 2; }
__host__ __device__ __forceinline__ int perm32(int rho) { const int n = rho >> 4, i = rho & 15; return 8 * (i >> 2) + 4 * n + (i & 3); }

struct Unit { int pm, pn; };
struct Gemm { const bf16_t* A; const bf16_t* Bt; int M, N, K; };

struct StaticOrder {
    int nM, nN, nwg, G, c;
    __host__ __device__ void init(int M, int N, int G_, int c_) { nM = M / BM; nN = N / BM; nwg = nM * nN; G = G_; c = c_; }
    __host__ __device__ bool next(int i, Unit& u) const {
        const long L = (long)i * G + c; if (L >= nwg) return false;
        int wgid = (int)L; { const int q = nwg / NXCD, r = nwg % NXCD, xcd = wgid % NXCD, off = wgid / NXCD; wgid = (xcd < r ? xcd * (q + 1) : r * (q + 1) + (xcd - r) * q) + off; }
        const int nig = WGM * nN, gid = wgid / nig, fm = gid * WGM, gsz = (nM - fm) < WGM ? (nM - fm) : WGM;
        u.pm = fm + ((wgid % nig) % gsz); u.pn = (wgid % nig) / gsz; return true;
    }
    __device__ __forceinline__ void a_ready(const Unit&) const {}
    __device__ __forceinline__ void done(const Unit&) const {}
};


__device__ __forceinline__ unsigned cvt_pk_bf16(float lo, float hi) { typedef float f2 __attribute__((ext_vector_type(2))); typedef __bf16 b2 __attribute__((ext_vector_type(2))); f2 v = {lo, hi}; b2 b = __builtin_convertvector(v, b2); return __builtin_bit_cast(unsigned, b); }
__device__ __forceinline__ float sigm(float v) { return __builtin_amdgcn_rcpf(1.0f + __builtin_amdgcn_exp2f(-1.4426950408889634f * v)); }
__device__ __forceinline__ void rows_rstd8(const float* ssq, int row0, int fq, float (&rs)[2][4]) {
    f32x4 p[2][4];
#pragma unroll
    for (int ai = 0; ai < 2; ++ai)
#pragma unroll
        for (int m = 0; m < 4; ++m) p[ai][m] = ((const f32x4*)(ssq + (size_t)(row0 + ai * HALF + m * 16) * 16))[fq];
#pragma unroll
    for (int ai = 0; ai < 2; ++ai)
#pragma unroll
        for (int m = 0; m < 4; ++m) { float v = (p[ai][m][0] + p[ai][m][1]) + (p[ai][m][2] + p[ai][m][3]); v += __shfl_xor(v, 16); v += __shfl_xor(v, 32); rs[ai][m] = __builtin_amdgcn_rsqf(v * (1.0f / 1024.0f) + 1e-6f); }
}
struct EpiProj {
    static constexpr bool PERM = true, AFTER_DRAIN = false, KEEP_ACC = false;
    bf16_t* O; int ldc; int sig_pn0; const float* ssq; bf16_t* rat; int Trows;
    __device__ __forceinline__ void operator()(const f32x4 (&acc)[2][2][4][2], const Unit& u, int wr, int wc, int fr, int fq) const {
        const int row0 = u.pm * BM + wr * 64 + fr; const int col0 = u.pn * BM + wc * 32 + 8 * fq;
        const bool sg = u.pn >= sig_pn0;
        float rs8[2][4]; rows_rstd8(ssq, row0, fq, rs8);
#pragma unroll
        for (int ai = 0; ai < 2; ++ai)
#pragma unroll
            for (int m = 0; m < 4; ++m) { bf16_t* rowp = O + (size_t)(row0 + ai * HALF + m * 16) * ldc + col0;
                const float rs_ = rs8[ai][m];
                f32x4 g0 = acc[ai][0][m][0] * rs_, g1 = acc[ai][0][m][1] * rs_, g2 = acc[ai][1][m][0] * rs_, g3 = acc[ai][1][m][1] * rs_;
                if (sg) {
#pragma unroll
                    for (int j = 0; j < 4; ++j) {
                        const float e0 = fminf(1.0f + __builtin_amdgcn_exp2f(-1.4426950408889634f * g0[j]), 1e6f), e1 = fminf(1.0f + __builtin_amdgcn_exp2f(-1.4426950408889634f * g1[j]), 1e6f);
                        const float e2 = fminf(1.0f + __builtin_amdgcn_exp2f(-1.4426950408889634f * g2[j]), 1e6f), e3 = fminf(1.0f + __builtin_amdgcn_exp2f(-1.4426950408889634f * g3[j]), 1e6f);
                        g0[j] = e1 * __builtin_amdgcn_rcpf(e0); g1[j] = e2 * __builtin_amdgcn_rcpf(e1); g2[j] = e3 * __builtin_amdgcn_rcpf(e2); g3[j] = __builtin_amdgcn_rcpf(e3); }
                }
                if (sg) { typedef unsigned u32x2 __attribute__((ext_vector_type(2)));
                    bf16_t* rp = rat + (size_t)(row0 + ai * HALF + m * 16) * 1024 + (u.pn - sig_pn0) * 64 + 16 * wc + 4 * fq; const size_t pl = (size_t)Trows * 1024;
                    { u32x2 w; w.x = cvt_pk_bf16(g0[0], g0[1]); w.y = cvt_pk_bf16(g0[2], g0[3]); *(u32x2*)rp = w; }
                    { u32x2 w; w.x = cvt_pk_bf16(g1[0], g1[1]); w.y = cvt_pk_bf16(g1[2], g1[3]); *(u32x2*)(rp + pl) = w; }
                    { u32x2 w; w.x = cvt_pk_bf16(g2[0], g2[1]); w.y = cvt_pk_bf16(g2[2], g2[3]); *(u32x2*)(rp + 2 * pl) = w; }
                    { u32x2 w; w.x = cvt_pk_bf16(g3[0], g3[1]); w.y = cvt_pk_bf16(g3[2], g3[3]); *(u32x2*)(rp + 3 * pl) = w; } }
                else {
                { u32x4 w; w.x = cvt_pk_bf16(g0[0], g0[1]); w.y = cvt_pk_bf16(g0[2], g0[3]); w.z = cvt_pk_bf16(g1[0], g1[1]); w.w = cvt_pk_bf16(g1[2], g1[3]); *(u32x4*)rowp = w; }
                { u32x4 w; w.x = cvt_pk_bf16(g2[0], g2[1]); w.y = cvt_pk_bf16(g2[2], g2[3]); w.z = cvt_pk_bf16(g3[0], g3[1]); w.w = cvt_pk_bf16(g3[2], g3[3]); *(u32x4*)(rowp + HALF) = w; } } }
    }
};
struct EpiBranch {
    static constexpr bool PERM = true, AFTER_DRAIN = false, KEEP_ACC = true;
    const bf16_t* rat; int Trows; bf16_t* mb; int nM;
    __device__ __forceinline__ void operator()(f32x4 (&acc)[2][2][4][2], const Unit& u, int wr, int wc, int fr, int fq) const {
        const int i = u.pn >> 2, pn = u.pn & 3, pm = u.pm - i * nM;
        { const int t_ = otid(), l_ = t_ & 63, w_ = t_ >> 6; wr = w_ >> 2; wc = w_ & 3; fr = l_ & 15; fq = l_ >> 4; }
        const int row0 = pm * BM + wr * 64 + fr; const int col0 = pn * BM + wc * 32 + 8 * fq;
        u32x4 gwv[2][4][2];
#pragma unroll
        for (int ai = 0; ai < 2; ++ai)
#pragma unroll
            for (int m = 0; m < 4; ++m) { const bf16_t* grow = rat + ((size_t)i * Trows + (row0 + ai * HALF + m * 16)) * 1024 + col0;
#pragma unroll
                for (int bj = 0; bj < 2; ++bj) gwv[ai][m][bj] = *(const u32x4*)(grow + bj * HALF); }
#pragma unroll
        for (int ai = 0; ai < 2; ++ai)
#pragma unroll
            for (int m = 0; m < 4; ++m) { bf16_t* brow = mb + (size_t)(row0 + ai * HALF + m * 16) * 1024 + col0;
#pragma unroll
                for (int bj = 0; bj < 2; ++bj) { const u32x4 gw = gwv[ai][m][bj]; u32x4 w = {0u, 0u, 0u, 0u};
#pragma unroll
                    for (int n = 0; n < 2; ++n) { const unsigned lo = gw[2 * n], hi_ = gw[2 * n + 1];
                        f32x4 g; g[0] = __uint_as_float(lo << 16); g[1] = __uint_as_float(lo & 0xffff0000u); g[2] = __uint_as_float(hi_ << 16); g[3] = __uint_as_float(hi_ & 0xffff0000u);
                        const f32x4 v = acc[ai][bj][m][n] * g; acc[ai][bj][m][n] = v;
                        if (i == 3) { w[2 * n] = cvt_pk_bf16(v[0], v[1]); w[2 * n + 1] = cvt_pk_bf16(v[2], v[3]); } }
                    if (i == 3) *(u32x4*)(brow + bj * HALF) = w; } }
    }
};
__device__ __forceinline__ float dpp_ror1(float x) { return __builtin_bit_cast(float, __builtin_amdgcn_update_dpp(0, __builtin_bit_cast(int, x), 0x121, 0xf, 0xf, false)); }
__device__ __forceinline__ float dpp_ror15(float x) { return __builtin_bit_cast(float, __builtin_amdgcn_update_dpp(0, __builtin_bit_cast(int, x), 0x12F, 0xf, 0xf, false)); }
struct EpiFfn {
    static constexpr bool PERM = true, AFTER_DRAIN = false, KEEP_ACC = false;
    bf16_t* act; float* edge; const float* ssq; const float* cw; const float* cb; int nblk;
    __device__ __forceinline__ void operator()(const f32x4 (&acc)[2][2][4][2], const Unit& u, int wr, int wc, int fr, int fq) const {
        typedef unsigned u32x2 __attribute__((ext_vector_type(2)));
        { const int t_ = otid(), l_ = t_ & 63, w_ = t_ >> 6; wr = w_ >> 2; wc = w_ & 3; fr = l_ & 15; fq = l_ >> 4; }
        const int row0 = u.pm * BM + wr * 64 + fr; const int ch0 = u.pn * 128 + wc * 32 + 8 * fq;
        constexpr bool r1up = true;
        const size_t esz = (size_t)nblk * 2 * 2816;
        float rs8[2][4]; rows_rstd8(ssq, row0, fq, rs8);
        f32x4 cwv[2][4];
#pragma unroll
        for (int n = 0; n < 2; ++n) { const int ch = ch0 + 4 * n; cwv[n][0] = *(const f32x4*)(cw + ch); cwv[n][1] = *(const f32x4*)(cw + 2816 + ch); cwv[n][2] = *(const f32x4*)(cw + 2 * 2816 + ch); cwv[n][3] = *(const f32x4*)(cb + ch); }
#pragma unroll
        for (int ai = 0; ai < 2; ++ai) {
            const int blk = (u.pm * BM + ai * HALF + wr * 64) >> 6;
            f32x4 ua_prev[2], db_next[2], gcur[2];
#pragma unroll
            for (int n = 0; n < 2; ++n) { gcur[n] = acc[ai][1][0][n] * rs8[ai][0]; ua_prev[n] = (f32x4){0.f, 0.f, 0.f, 0.f};
#pragma unroll
                for (int j = 0; j < 4; ++j) db_next[n][j] = dpp_ror15(gcur[n][j]); }
#pragma unroll
            for (int m = 0; m < 4; ++m) { f32x4 ua[2], db[2], gnext[2]; u32x4 w4; f32x4 cvs[2], uus[2];
                const bool isF = (m == 0) && (fr == 0), isL = (m == 3) && (fr == 15);
#pragma unroll
                for (int n = 0; n < 2; ++n) { db[n] = db_next[n];
#pragma unroll
                    for (int j = 0; j < 4; ++j) ua[n][j] = dpp_ror1(gcur[n][j]);
                    if (m < 3) { gnext[n] = acc[ai][1][m < 3 ? m + 1 : 3][n] * rs8[ai][m < 3 ? m + 1 : 3];
#pragma unroll
                        for (int j = 0; j < 4; ++j) db_next[n][j] = dpp_ror15(gnext[n][j]); }
                    else { gnext[n] = (f32x4){0.f, 0.f, 0.f, 0.f}; db_next[n] = gnext[n]; }
                    const f32x4 w0 = cwv[n][0], w1 = cwv[n][1], w2 = cwv[n][2], bb = cwv[n][3]; const f32x4 uu = acc[ai][0][m][n] * rs8[ai][m]; f32x4 cv;
#pragma unroll
                    for (int j = 0; j < 4; ++j) { const float up = (fr > 0) ? ua[n][j] : ua_prev[n][j]; const float dn = (fr < 15) ? db[n][j] : db_next[n][j];
                        cv[j] = w0[j] * up + w1[j] * gcur[n][j] + w2[j] * dn + bb[j]; }
                    cvs[n] = cv; uus[n] = uu;
                    f32x4 a4;
#pragma unroll
                    for (int j = 0; j < 4; ++j) a4[j] = cv[j] * sigm(cv[j]) * uu[j];
                    w4[2 * n] = cvt_pk_bf16(a4[0], a4[1]); w4[2 * n + 1] = cvt_pk_bf16(a4[2], a4[3]); }
                if (isF || isL) { float* e = edge + ((size_t)blk * 2 + (isL ? 1 : 0)) * 2816 + ch0;
#pragma unroll
                    for (int n = 0; n < 2; ++n) { *(f32x4*)(e + 4 * n) = cvs[n]; *(f32x4*)(e + esz + 4 * n) = uus[n]; *(f32x4*)(e + 2 * esz + 4 * n) = gcur[n]; } }
                else *(u32x4*)(act + (size_t)(row0 + ai * HALF + m * 16) * 2816 + ch0) = w4;
#pragma unroll
                for (int n = 0; n < 2; ++n) { ua_prev[n] = ua[n]; gcur[n] = gnext[n]; }
            }
            asm volatile("" ::: "memory");
        }
    }
};
struct EpiResid {
    static constexpr bool PERM = true, AFTER_DRAIN = false, KEEP_ACC = false;
    bf16_t* xr; float* ssq;
    __device__ __forceinline__ void operator()(const f32x4 (&acc)[2][2][4][2], const Unit& u, int wr, int wc, int fr, int fq) const {
        const int row0 = u.pm * BM + wr * 64 + fr; const int col0 = u.pn * BM + wc * 32 + 8 * fq;
        u32x4 owv[2][4][2];
#pragma unroll
        for (int ai = 0; ai < 2; ++ai)
#pragma unroll
            for (int m = 0; m < 4; ++m) { const bf16_t* xp = xr + (size_t)(row0 + ai * HALF + m * 16) * 1024 + col0;
#pragma unroll
                for (int bj = 0; bj < 2; ++bj) owv[ai][m][bj] = *(const u32x4*)(xp + bj * HALF); }
#pragma unroll
        for (int ai = 0; ai < 2; ++ai)
#pragma unroll
            for (int m = 0; m < 4; ++m) { const int row = row0 + ai * HALF + m * 16; bf16_t* xp = xr + (size_t)row * 1024 + col0; float sq = 0.f;
#pragma unroll
                for (int bj = 0; bj < 2; ++bj) { const u32x4 ow = owv[ai][m][bj]; u32x4 w;
#pragma unroll
                    for (int n = 0; n < 2; ++n) { f32x4 v = acc[ai][bj][m][n]; const unsigned lo = ow[2 * n], hi_ = ow[2 * n + 1];
                        v[0] += __uint_as_float(lo << 16); v[1] += __uint_as_float(lo & 0xffff0000u); v[2] += __uint_as_float(hi_ << 16); v[3] += __uint_as_float(hi_ & 0xffff0000u);
                        sq += (v[0] * v[0] + v[1] * v[1]) + (v[2] * v[2] + v[3] * v[3]);
                        w[2 * n] = cvt_pk_bf16(v[0], v[1]); w[2 * n + 1] = cvt_pk_bf16(v[2], v[3]); }
                    *(u32x4*)(xp + bj * HALF) = w; }
                sq += __shfl_xor(sq, 16); sq += __shfl_xor(sq, 32);
                if (fq == 0) ssq[(size_t)row * 16 + u.pn * 4 + wc] = sq; }
    }
};
struct BranchOrder {
    int nM, G, c;
    __device__ bool next(int i, Unit& u) const { const int tl = (i >> 2) * G + c; if (tl >= nM * 4) return false; const int sub = i & 3; u.pm = sub * nM + (tl >> 2); u.pn = sub * 4 + (tl & 3); return true; }
    __device__ __forceinline__ void a_ready(const Unit&) const {}
    __device__ __forceinline__ void done(const Unit&) const {}
};

template <class Epi, class Sched, bool ALIGN_EPI = false, bool SP2 = false>
__device__ __forceinline__ void gemm_phase(PG8_LAS unsigned char* lds, const Gemm g, const Sched& S, const Epi& E) {
    const int tid = otid(), wid = __builtin_amdgcn_readfirstlane(tid >> 6), lane = tid & 63, wr = wid >> 2, wc = wid & 3, fr = lane & 15, fq = lane >> 4;
    const int K = g.K, nt = K / BK;
    unsigned voffA[2], voffB[2];
#pragma unroll
    for (int i = 0; i < 2; ++i) { int R, C; stage_rc(tid * 16 + i * 8192, R, C); const int Rb = Epi::PERM ? ((R & ~31) + perm32(R & 31)) : R;
        voffA[i] = (unsigned)(R * K + C) * 2u; voffB[i] = (unsigned)(Rb * K + C) * 2u; }
    const size_t kstep = (size_t)(BK * 2);
    const size_t hstep = (size_t)HALF * K * 2;
    const size_t tstep = 2 * hstep;
    const unsigned ldsw = (unsigned)wid * 1024u;
    const int aoff = lds_byte(wr * 64 + fr, fq * 8), boff = lds_byte(wc * 32 + fr, fq * 8);
#define PG8_SA(b, h) (((b) * 2 + (h)) * HTB)
#define PG8_SB(b, h) ((4 + (b) * 2 + (h)) * HTB)
#define PG8_STAGE(bufoff, gbase, voff) do { _Pragma("unroll") for (int _i = 0; _i < 2; ++_i) \
        __builtin_amdgcn_global_load_lds((const unsigned*)((const char*)(gbase) + (voff)[_i]), (PG8_LAS unsigned*)(lds + (bufoff) + ldsw + _i * 8192), 16, 0, 0); } while (0)
#define PG8_LDA(dst, b, h) do { _Pragma("unroll") for (int m = 0; m < 4; ++m) _Pragma("unroll") for (int k = 0; k < 2; ++k) dst[m][k] = *(const PG8_LAS bf16x8*)(lds + PG8_SA(b, h) + aoff + m * 2048 + k * 1024); } while (0)
#define PG8_LDB(dst, b, h) do { _Pragma("unroll") for (int n = 0; n < 2; ++n) _Pragma("unroll") for (int k = 0; k < 2; ++k) dst[n][k] = *(const PG8_LAS bf16x8*)(lds + PG8_SB(b, h) + boff + n * 2048 + k * 1024); } while (0)
#define PG8_MMA(ai, bj, At, Bt) do { __builtin_amdgcn_s_setprio(1); _Pragma("unroll") for (int m = 0; m < 4; ++m) _Pragma("unroll") for (int n = 0; n < 2; ++n) _Pragma("unroll") for (int k = 0; k < 2; ++k) \
        acc[ai][bj][m][n] = __builtin_amdgcn_mfma_f32_16x16x32_bf16(Bt[n][k], At[m][k], acc[ai][bj][m][n], 0, 0, 0); __builtin_amdgcn_s_setprio(0); } while (0)
#define PG8_WAIT_V(n) asm volatile("s_waitcnt vmcnt(" #n ")" ::: "memory")
#define PG8_WAIT_L(n) asm volatile("s_waitcnt lgkmcnt(" #n ")" ::: "memory")
#define PG8_BAR __builtin_amdgcn_s_barrier()
#define PG8_SCHED __builtin_amdgcn_sched_barrier(0)
    Unit cur, nxt; int ui = 0;
    if (!S.next(0, cur)) return;
    f32x4 acc[2][2][4][2];
#pragma unroll
    for (int a = 0; a < 2; ++a)
#pragma unroll
        for (int b = 0; b < 2; ++b)
#pragma unroll
            for (int m = 0; m < 4; ++m)
#pragma unroll
                for (int n = 0; n < 2; ++n) acc[a][b][m][n] = (f32x4){0.f, 0.f, 0.f, 0.f};
    bf16x8 At[4][2], B0[2][2], B1[2][2];
    const char* cA = (const char*)g.A + (size_t)cur.pm * tstep; const char* cB = (const char*)g.Bt + (size_t)cur.pn * tstep;
    S.a_ready(cur);
    if constexpr (SP2) {
        PG8_STAGE(PG8_SB(0, 0), cB, voffB); PG8_STAGE(PG8_SB(0, 1), cB + hstep, voffB); PG8_STAGE(PG8_SA(0, 0), cA, voffA); PG8_STAGE(PG8_SA(0, 1), cA + hstep, voffA);
        if (wr == 1) PG8_BAR;
        PG8_WAIT_V(2); PG8_BAR;
        PG8_STAGE(PG8_SB(1, 0), cB + kstep, voffB); PG8_STAGE(PG8_SA(1, 0), cA + kstep, voffA); PG8_STAGE(PG8_SB(1, 1), cB + hstep + kstep, voffB);
        PG8_WAIT_V(6); PG8_BAR;
    } else {
        PG8_STAGE(PG8_SB(0, 0), cB, voffB); PG8_STAGE(PG8_SA(0, 0), cA, voffA); PG8_STAGE(PG8_SB(0, 1), cB + hstep, voffB); PG8_STAGE(PG8_SA(0, 1), cA + hstep, voffA);
        if (wr == 1) PG8_BAR;
        PG8_WAIT_V(4); PG8_BAR;
        PG8_STAGE(PG8_SB(1, 0), cB + kstep, voffB); PG8_STAGE(PG8_SA(1, 0), cA + kstep, voffA); PG8_STAGE(PG8_SB(1, 1), cB + hstep + kstep, voffB);
        PG8_WAIT_V(6); PG8_BAR;
    }
    for (;;) {
        const bool has_next = S.next(ui + 1, nxt);
        const char* nA = has_next ? (const char*)g.A + (size_t)nxt.pm * tstep : cA; const char* nB = has_next ? (const char*)g.Bt + (size_t)nxt.pn * tstep : cB;
        for (int t = 0; t < nt; t += 2) {
            const bool last = (t == nt - 2);
            const char* a1 = cA + (size_t)(t + 1) * kstep;
            const char* a2 = last ? nA : cA + (size_t)(t + 2) * kstep; const char* b2 = last ? nB : cB + (size_t)(t + 2) * kstep;
            const char* a3 = a2 + kstep; const char* b3 = b2 + kstep;
            if (last && has_next) S.a_ready(nxt);
            if constexpr (SP2) {
            PG8_LDB(B0, 0, 0); PG8_LDB(B1, 0, 1); PG8_SCHED; PG8_LDA(At, 0, 0); PG8_STAGE(PG8_SA(1, 1), a1 + hstep, voffA);
            PG8_WAIT_V(8); PG8_WAIT_L(0); PG8_BAR; PG8_MMA(0, 0, At, B0); PG8_MMA(0, 1, At, B1); PG8_BAR; PG8_SCHED;
            PG8_LDA(At, 0, 1); PG8_STAGE(PG8_SB(0, 0), b2, voffB); PG8_STAGE(PG8_SB(0, 1), b2 + hstep, voffB); PG8_STAGE(PG8_SA(0, 0), a2, voffA);
            PG8_WAIT_V(8); PG8_WAIT_L(0); PG8_BAR; PG8_MMA(1, 0, At, B0); PG8_MMA(1, 1, At, B1); PG8_BAR; PG8_SCHED;
            PG8_LDB(B0, 1, 0); PG8_LDB(B1, 1, 1); PG8_SCHED; PG8_LDA(At, 1, 0); PG8_STAGE(PG8_SA(0, 1), a2 + hstep, voffA);
            PG8_WAIT_V(8); PG8_WAIT_L(0); PG8_BAR; PG8_MMA(0, 0, At, B0); PG8_MMA(0, 1, At, B1); PG8_BAR; PG8_SCHED;
            PG8_LDA(At, 1, 1); PG8_STAGE(PG8_SB(1, 0), b3, voffB); PG8_STAGE(PG8_SB(1, 1), b3 + hstep, voffB); PG8_STAGE(PG8_SA(1, 0), a3, voffA);
            PG8_WAIT_V(8); PG8_WAIT_L(0); PG8_BAR; PG8_MMA(1, 0, At, B0); PG8_MMA(1, 1, At, B1); PG8_BAR; PG8_SCHED;
            } else {
            PG8_LDB(B0, 0, 0); PG8_SCHED; PG8_LDA(At, 0, 0); PG8_STAGE(PG8_SA(1, 1), a1 + hstep, voffA);
            PG8_WAIT_L(8); PG8_BAR; PG8_WAIT_L(0); PG8_MMA(0, 0, At, B0); PG8_BAR; PG8_SCHED;
            PG8_LDB(B1, 0, 1); PG8_STAGE(PG8_SB(0, 0), b2, voffB);
            PG8_BAR; PG8_WAIT_L(0); PG8_MMA(0, 1, At, B1); PG8_BAR;
            PG8_LDA(At, 0, 1); PG8_STAGE(PG8_SA(0, 0), a2, voffA);
            PG8_BAR; PG8_WAIT_L(0); PG8_MMA(1, 0, At, B0); PG8_BAR; PG8_SCHED;
            PG8_STAGE(PG8_SB(0, 1), b2 + hstep, voffB);
            PG8_WAIT_V(6); PG8_BAR; PG8_MMA(1, 1, At, B1); PG8_BAR;
            PG8_LDB(B0, 1, 0); PG8_SCHED; PG8_LDA(At, 1, 0); PG8_STAGE(PG8_SA(0, 1), a2 + hstep, voffA);
            PG8_WAIT_L(8); PG8_BAR; PG8_WAIT_L(0); PG8_MMA(0, 0, At, B0); PG8_BAR; PG8_SCHED;
            PG8_LDB(B1, 1, 1); PG8_STAGE(PG8_SB(1, 0), b3, voffB);
            PG8_BAR; PG8_WAIT_L(0); PG8_MMA(0, 1, At, B1); PG8_BAR;
            PG8_LDA(At, 1, 1); PG8_STAGE(PG8_SA(1, 0), a3, voffA);
            PG8_BAR; PG8_WAIT_L(0); PG8_MMA(1, 0, At, B0); PG8_BAR; PG8_SCHED;
            PG8_STAGE(PG8_SB(1, 1), b3 + hstep, voffB);
            PG8_WAIT_V(6); PG8_BAR; PG8_MMA(1, 1, At, B1); PG8_BAR;
            }
        }
        if constexpr (ALIGN_EPI) { if (wr == 0) PG8_BAR; }
        if constexpr (!Epi::AFTER_DRAIN) { E(acc, cur, wr, wc, fr, fq); S.done(cur); }
        if (!has_next) break;
        if (!Epi::KEEP_ACC || ((ui + 1) & 3) == 0) {
#pragma unroll
        for (int a = 0; a < 2; ++a)
#pragma unroll
            for (int b = 0; b < 2; ++b)
#pragma unroll
                for (int m = 0; m < 4; ++m)
#pragma unroll
                    for (int n = 0; n < 2; ++n) acc[a][b][m][n] = (f32x4){0.f, 0.f, 0.f, 0.f};
        }
        cur = nxt; cA = nA; cB = nB; ++ui;
        if constexpr (ALIGN_EPI) { if (wr == 1) PG8_BAR; }
    }
    PG8_WAIT_V(0);
    if constexpr (!ALIGN_EPI) { if (wr == 0) PG8_BAR; }
    PG8_BAR;
    if constexpr (Epi::AFTER_DRAIN) { E.fused(acc, cur, wr, wc, fr, fq, lds, wid, lane); S.done(cur); }
#undef PG8_SA
#undef PG8_SB
#undef PG8_STAGE
#undef PG8_LDA
#undef PG8_LDB
#undef PG8_MMA
#undef PG8_WAIT_V
#undef PG8_WAIT_L
#undef PG8_BAR
#undef PG8_SCHED
}
}
#define LAS __attribute__((address_space(3)))
typedef unsigned short bf16_t;
typedef short bf16x8 __attribute__((ext_vector_type(8)));
typedef short v4i16_t __attribute__((ext_vector_type(4)));
typedef float f32x4 __attribute__((ext_vector_type(4)));
typedef float f32x16 __attribute__((ext_vector_type(16)));
typedef unsigned u32x4 __attribute__((ext_vector_type(4)));
typedef unsigned u32x2 __attribute__((ext_vector_type(2)));
using pg8::cvt_pk_bf16;

constexpr int DM = 1024, SEQ = 2048, NSEQ = 40, NTOK_P = 32 * SEQ, NTOK = NSEQ * SEQ, DEPTH = 2;
constexpr int TMAX = 32768, NGROUP = 3;
constexpr int NPROJ = 6656;
constexpr int PPITCH = 2560;
constexpr int PA = 0, PB = 768, PD = 1536, PC = 2048, PG = 2560;
constexpr int FF = 2816, NUG = 2 * FF;
constexpr float EPS = 1e-6f, LOG2E = 1.4426950408889634f;
constexpr int NWAVES = 8, NTHR = 512;

constexpr size_t al256(size_t x) { return (x + 255) & ~(size_t)255; }
constexpr size_t WS_WIN = 1 << 20;
constexpr size_t WS_WBR = WS_WIN + al256((size_t)DEPTH * NPROJ * DM * 2);
constexpr size_t WS_WOUT = WS_WBR + al256((size_t)DEPTH * 4 * 1024 * 256 * 2);
constexpr size_t WS_WFI = WS_WOUT + al256((size_t)DEPTH * DM * DM * 2);
constexpr size_t WS_WFO = WS_WFI + al256((size_t)DEPTH * NUG * DM * 2);
constexpr size_t WS_WUQ = WS_WFO + al256((size_t)DEPTH * DM * FF * 2);
constexpr size_t WS_WUKV = WS_WUQ + al256((size_t)DEPTH * 384 * 192 * 2);
constexpr size_t WS_ROPE = WS_WUKV + al256((size_t)DEPTH * 512 * 128 * 2);
constexpr size_t WS_XN = WS_ROPE + al256((size_t)2048 * 16 * 8);
constexpr size_t WS_PROJ = WS_XN + al256((size_t)TMAX * DM * 2);
constexpr size_t WS_RAT = WS_PROJ + al256((size_t)TMAX * PPITCH * 2);
constexpr size_t WS_QC = WS_RAT + al256((size_t)4 * TMAX * 1024 * 2);
constexpr size_t WS_KC = WS_QC + al256((size_t)TMAX * 384 * 2);
constexpr size_t WS_VC = WS_KC + al256((size_t)TMAX * 384 * 2);
constexpr size_t WS_OB = WS_VC + al256((size_t)TMAX * 256 * 2);
constexpr size_t WS_MRG = WS_OB + al256((size_t)4 * TMAX * 256 * 2);
constexpr size_t WS_MB = WS_MRG + al256((size_t)48 << 20);
constexpr size_t WS_UG = WS_MB + al256((size_t)TMAX * DM * 2);
constexpr size_t WS_ACT = WS_UG;
constexpr size_t WS_END = WS_ACT + al256((size_t)TMAX * FF * 2);
static_assert(WS_END <= ((size_t)1 << 30), "workspace map exceeds 1 GiB");
static_assert((size_t)64 * TMAX * 4 + (size_t)3 * (TMAX / 64) * 2 * 2816 * 4 <= ((size_t)48 << 20), "MRG region");

constexpr int LDS_BYTES = 135168;

struct Args { const float* in[24]; float* out; unsigned char* ws; };
#ifndef PH_MASK
#define PH_MASK 0xFFFF
#endif
#ifndef FLK
#define FLK 15
#endif
#ifndef DUP_MASK
#define DUP_MASK 0
#endif
#define PH(k) _Pragma("unroll 1") for (int rep_ = 0; rep_ < (int)(((PH_MASK >> (k)) & 1) + ((DUP_MASK >> (k)) & 1)); ++rep_)

__device__ __forceinline__ float bf2f(bf16_t b) { return __uint_as_float((unsigned)b << 16); }
__device__ __forceinline__ bf16_t f2bf(float f) { return (bf16_t)(cvt_pk_bf16(f, 0.f) & 0xffffu); }
__device__ __forceinline__ float wave_sum(float v) {
#pragma unroll
    for (int o = 1; o < 64; o <<= 1) v += __shfl_xor(v, o);
    return v;
}
__device__ __forceinline__ int crow(int r, int hi) { return (r & 3) + 8 * (r >> 2) + 4 * hi; }
__device__ __forceinline__ v4i16_t vtr(LAS const char* p) { return __builtin_amdgcn_ds_read_tr16_b64_v4i16((LAS v4i16_t*)p); }
#define MFMA32(a, b, c) __builtin_amdgcn_mfma_f32_32x32x16_bf16((a), (b), (c), 0, 0, 0)
#define MFMA16(a, b, c) __builtin_amdgcn_mfma_f32_16x16x32_bf16((a), (b), (c), 0, 0, 0)

__device__ __forceinline__ void transpose_item(const float* W, int K, int N, bf16_t* WT, int n0d, int n0s, float scale, int k0, float* scr, int lane, bool gperm = false, const float* kgain = nullptr) {
    if (gperm) {
        const int cg = n0d - PG + (lane & 31), tg = cg >> 8, cc = cg & 255, gi = 2 * (cc >> 7) + ((cc >> 2) & 1), ch = tg * 64 + 16 * ((cc >> 5) & 3) + 4 * ((cc >> 3) & 3) + (cc & 3);
        const int src = 2400 + gi * 1024 + ch;
#pragma unroll
        for (int i = 0; i < 32; ++i) { const int kk = 2 * i + (lane >> 5); scr[kk * 33 + (lane & 31)] = W[(size_t)(k0 + kk) * N + src] * kgain[k0 + kk]; }
    } else if (n0s >= 0) {
#pragma unroll
        for (int i = 0; i < 32; ++i) { const int kk = 2 * i + (lane >> 5); scr[kk * 33 + (lane & 31)] = W[(size_t)(k0 + kk) * N + n0s + (lane & 31)] * (kgain ? scale * kgain[k0 + kk] : scale); }
    } else {
#pragma unroll
        for (int i = 0; i < 32; ++i) { const int kk = 2 * i + (lane >> 5); scr[kk * 33 + (lane & 31)] = 0.f; }
    }
    __builtin_amdgcn_wave_barrier(); asm volatile("s_waitcnt lgkmcnt(0)" ::: "memory");
    const int c = lane & 7;
#pragma unroll
    for (int j = 0; j < 4; ++j) { const int n = (lane >> 3) + 8 * j; const float* s = scr + (8 * c) * 33 + n;
        u32x4 o; o.x = cvt_pk_bf16(s[0 * 33], s[1 * 33]); o.y = cvt_pk_bf16(s[2 * 33], s[3 * 33]); o.z = cvt_pk_bf16(s[4 * 33], s[5 * 33]); o.w = cvt_pk_bf16(s[6 * 33], s[7 * 33]);
        *(u32x4*)(WT + (size_t)(n0d + n) * K + k0 + 8 * c) = o; }
    __builtin_amdgcn_wave_barrier(); asm volatile("s_waitcnt lgkmcnt(0)" ::: "memory");
}
__device__ __forceinline__ void prologue(const Args& a, unsigned char* ws, char* lds, int gw, int NGW, int wave, int lane) {
    float* scr = (float*)(lds + wave * 16384);
    constexpr int I_IN = 16 * (NPROJ / 32), I_BR = 4 * 4 * 32, I_OUT = 16 * 32, I_FI = 16 * (NUG / 32), I_FO = (FF / 64) * 32, I_UQ = 3 * 12, I_UKV = 2 * 16;
    constexpr int PER_L = I_IN + I_BR + I_OUT + I_FI + I_FO + I_UQ + I_UKV;
    for (int it = gw; it < DEPTH * PER_L; it += NGW) {
        const int l = it / PER_L; int r = it % PER_L;
        if (r < I_IN) { const int nb = r % (NPROJ / 32), kb = r / (NPROJ / 32); const int n0d = nb * 32; int n0s; float sc = 1.f;
            if (n0d < PD) { n0s = n0d; if (n0d < 256) sc = 0.17677669529663687f * LOG2E; else if (n0d >= PB && n0d < PB + 256) sc = 0.125f * LOG2E; }
            else if (n0d < PC) n0s = n0d - PD + 1888;
            else if (n0d < PC + 352) n0s = n0d - PC + 1536;
            else if (n0d < PG) n0s = -1;
            else n0s = n0d - PG + 2400;
            transpose_item(a.in[3] + (size_t)l * DM * 6496, DM, 6496, (bf16_t*)(ws + WS_WIN) + (size_t)l * NPROJ * DM, n0d, n0s, sc, kb * 64, scr, lane, n0d >= PG, a.in[2] + l * DM); continue; }
        r -= I_IN;
        if (r < I_BR) { const int i = r / 128, rr = r % 128, nb = rr % 32, kb = rr / 32;
            transpose_item(a.in[16] + ((size_t)l * 4 + i) * 256 * 1024, 256, 1024, (bf16_t*)(ws + WS_WBR) + ((size_t)l * 4 + i) * 1024 * 256, nb * 32, nb * 32, 1.f, kb * 64, scr, lane); continue; }
        r -= I_BR;
        if (r < I_OUT) { const int nb = r % 32, kb = r / 32;
            transpose_item(a.in[17] + (size_t)l * DM * DM, DM, DM, (bf16_t*)(ws + WS_WOUT) + (size_t)l * DM * DM, nb * 32, nb * 32, 1.f, kb * 64, scr, lane); continue; }
        r -= I_OUT;
        if (r < I_FI) { const int nb = r % (NUG / 32), kb = r / (NUG / 32);
            const int n0d = nb * 32, src0 = ((n0d >> 7) & 1) * FF + (n0d >> 8) * 128 + (n0d & 127);
            transpose_item(a.in[19] + (size_t)l * DM * NUG, DM, NUG, (bf16_t*)(ws + WS_WFI) + (size_t)l * NUG * DM, n0d, src0, 1.f, kb * 64, scr, lane, false, a.in[18] + l * DM); continue; }
        r -= I_FI;
        if (r < I_FO) { const int nb = r % 32, kb = r / 32;
            transpose_item(a.in[22] + (size_t)l * FF * DM, FF, DM, (bf16_t*)(ws + WS_WFO) + (size_t)l * DM * FF, nb * 32, nb * 32, 1.f, kb * 64, scr, lane); continue; }
        r -= I_FO;
        if (r < I_UQ) { const int nb = r % 12, kb = r / 12;
            transpose_item(a.in[12] + (size_t)l * 192 * 384, 192, 384, (bf16_t*)(ws + WS_WUQ) + (size_t)l * 384 * 192, nb * 32, nb * 32, 1.f, kb * 64, scr, lane); continue; }
        r -= I_UQ;
        { const int nb = r % 16, kb = r / 16;
            transpose_item(a.in[13] + (size_t)l * 128 * 512, 128, 512, (bf16_t*)(ws + WS_WUKV) + (size_t)l * 512 * 128, nb * 32, nb * 32, 1.f, kb * 64, scr, lane); }
    }
    float2* rope = (float2*)(ws + WS_ROPE);
    for (int e = gw * 64 + lane; e < 2048 * 16; e += NGW * 64) {
        const int pos = e >> 4, i = e & 15;
        const float inv = exp2f(-(float)i * (13.287712379549449f / 16.0f));
        const float ang = (float)pos * inv;
        const double rev = (double)ang * 0.15915494309189535; const double fr = rev - __builtin_rint(rev);
        rope[e] = make_float2(__builtin_amdgcn_cosf((float)fr), __builtin_amdgcn_sinf((float)fr));
    }
}

__device__ __forceinline__ void convert_phase(const float* xa, const float* xb, int row_g0, int T, bf16_t* XR, float* S0, int gw, int NGW, int lane) {
#pragma unroll 1
    for (int m0 = gw; m0 < T; m0 += 2 * NGW) { const int m1 = (m0 + NGW < T) ? m0 + NGW : m0;
        f32x4 v[2][4];
#pragma unroll
        for (int k = 0; k < 2; ++k) { const int R = row_g0 + (k ? m1 : m0); const float* xr = (R < NTOK_P) ? xa + (size_t)R * DM : xb + (size_t)(R - NTOK_P) * DM;
#pragma unroll
            for (int j = 0; j < 4; ++j) v[k][j] = __builtin_nontemporal_load(((const f32x4*)xr) + lane + 64 * j); }
#pragma unroll
        for (int k = 0; k < 2; ++k) { const int m = k ? m1 : m0; float s = 0.f;
#pragma unroll
            for (int j = 0; j < 4; ++j) s += (v[k][j].x * v[k][j].x + v[k][j].y * v[k][j].y) + (v[k][j].z * v[k][j].z + v[k][j].w * v[k][j].w);
            s = wave_sum(s);
            u32x2* o8 = (u32x2*)(XR + (size_t)m * DM);
#pragma unroll
            for (int j = 0; j < 4; ++j) { u32x2 w; w.x = cvt_pk_bf16(v[k][j].x, v[k][j].y); w.y = cvt_pk_bf16(v[k][j].z, v[k][j].w); o8[lane + 64 * j] = w; }
            if (lane < 16) S0[(size_t)m * 16 + lane] = (lane == 0) ? s : 0.f; }
    }
}
__device__ __forceinline__ void final_norm_phase(float* out, int row_g0, int T, const bf16_t* XR, const float* S0, const float* gain, int gw, int NGW, int lane) {
    f32x4 g[4];
#pragma unroll
    for (int j = 0; j < 4; ++j) g[j] = ((const f32x4*)gain)[lane + 64 * j];
#pragma unroll 1
    for (int m0 = gw; m0 < T; m0 += 2 * NGW) { const int m1 = (m0 + NGW < T) ? m0 + NGW : m0;
        u32x2 w[2][4]; f32x4 sp[2][4];
#pragma unroll
        for (int k = 0; k < 2; ++k) { const int m = k ? m1 : m0; const u32x2* x8 = (const u32x2*)(XR + (size_t)m * DM);
#pragma unroll
            for (int j = 0; j < 4; ++j) { w[k][j] = x8[lane + 64 * j]; sp[k][j] = ((const f32x4*)(S0 + (size_t)m * 16))[j]; } }
#pragma unroll
        for (int k = 0; k < 2; ++k) { const int m = k ? m1 : m0; float* orow = out + (size_t)(row_g0 + m) * DM;
            const float sq_ = (((sp[k][0][0] + sp[k][0][1]) + (sp[k][0][2] + sp[k][0][3])) + ((sp[k][1][0] + sp[k][1][1]) + (sp[k][1][2] + sp[k][1][3]))) + (((sp[k][2][0] + sp[k][2][1]) + (sp[k][2][2] + sp[k][2][3])) + ((sp[k][3][0] + sp[k][3][1]) + (sp[k][3][2] + sp[k][3][3])));
            const float rstd = 1.0f / sqrtf(sq_ * (1.f / DM) + EPS);
#pragma unroll
            for (int j = 0; j < 4; ++j) { f32x4 v; v.x = __uint_as_float(w[k][j].x << 16) * rstd * g[j].x; v.y = __uint_as_float(w[k][j].x & 0xffff0000u) * rstd * g[j].y; v.z = __uint_as_float(w[k][j].y << 16) * rstd * g[j].z; v.w = __uint_as_float(w[k][j].y & 0xffff0000u) * rstd * g[j].w;
                __builtin_nontemporal_store(v, ((f32x4*)orow) + lane + 64 * j); } }
    }
}
__device__ __forceinline__ void conv_fix_phase(const float* edge, bf16_t* ACT, const float* cw, int T, int gtid, int NT) {
    constexpr int NCH = FF / 8; const int NBLK = T / 64; const size_t esz = (size_t)NBLK * 2 * FF;
#pragma unroll 1
    for (int idx = gtid; idx < NBLK * 2 * NCH; idx += NT) { const int ch = (idx % NCH) * 8, bw = idx / NCH, which = bw & 1, blk = bw >> 1;
        const int row = blk * 64 + (which ? 63 : 0), pos = row & (SEQ - 1);
        const bool nb_ok = which ? (pos < SEQ - 1) : (pos > 0);
        const float* e = edge + (size_t)bw * FF + ch; const float* wv = cw + (which ? 2 * FF : 0) + ch;
        const float* gn = edge + 2 * esz + (size_t)(which ? (blk + 1) * 2 : (blk - 1) * 2 + 1) * FF + ch;
        u32x4 o;
#pragma unroll
        for (int q = 0; q < 2; ++q) { const f32x4 cv = ((const f32x4*)e)[q], uu = ((const f32x4*)(e + esz))[q], wq = ((const f32x4*)wv)[q]; f32x4 gq = {0.f, 0.f, 0.f, 0.f}; if (nb_ok) gq = ((const f32x4*)gn)[q];
            float r[4];
#pragma unroll
            for (int j = 0; j < 4; ++j) { const float c = cv[j] + wq[j] * gq[j]; r[j] = c * pg8::sigm(c) * uu[j]; }
            o[2 * q] = cvt_pk_bf16(r[0], r[1]); o[2 * q + 1] = cvt_pk_bf16(r[2], r[3]); }
        *(u32x4*)(ACT + (size_t)row * FF + ch) = o; }
}

template <int NTK>
__device__ __forceinline__ void pp_elem(const int (&toks)[NTK], bf16_t* PROJ, bf16_t* KC, const float2* rope, const float* dqn, const float* dkn, int lane) {
    int e0, c, sec = 0; bool isD = false; float sc = 1.f; const float* gn = dqn;
    if (lane < 32) { sec = lane >> 1; c = lane & 1; e0 = PA + sec * 32 + c * 8; }
    else if (lane < 56) { const int t = lane - 32, hd = t >> 2; sec = (t >> 1) & 1; c = t & 1; e0 = PD + hd * 64 + sec * 32 + c * 8; isD = true; gn = ((hd < 4) ? dqn : dkn) + sec * 32 + c * 8; sc = (hd < 4) ? 0.125f * LOG2E : 1.f; }
    else { c = lane & 1; e0 = PC + 320 + c * 8; }
    const bool active = lane < 58, isC = lane >= 56;
    u32x4 xa[NTK], xb[NTK]; f32x4 rp[NTK][4];
#pragma unroll
    for (int k = 0; k < NTK; ++k) { const int tok = toks[k], pos = tok & (SEQ - 1); const bf16_t* row = PROJ + (size_t)tok * PPITCH + e0;
        const int pe = isD ? (sec ? (pos & 63) : (pos >> 6)) : pos; const f32x4* rq = (const f32x4*)(rope + pe * 16 + c * 8);
        if (active) { xa[k] = *(const u32x4*)row; xb[k] = *(const u32x4*)(row + 16); } else { xa[k] = (u32x4){0u, 0u, 0u, 0u}; xb[k] = xa[k]; }
#pragma unroll
        for (int q = 0; q < 4; ++q) rp[k][q] = rq[q]; }
    f32x4 g1[2], g2[2];
#pragma unroll
    for (int q = 0; q < 2; ++q) { g1[q] = *(const f32x4*)(gn + 4 * q); g2[q] = *(const f32x4*)(gn + 16 + 4 * q); }
#pragma unroll
    for (int k = 0; k < NTK; ++k) { const int tok = toks[k];
        float x1[8], x2[8]; float ss = 0.f;
#pragma unroll
        for (int q = 0; q < 4; ++q) { x1[2 * q] = __uint_as_float(xa[k][q] << 16); x1[2 * q + 1] = __uint_as_float(xa[k][q] & 0xffff0000u); x2[2 * q] = __uint_as_float(xb[k][q] << 16); x2[2 * q + 1] = __uint_as_float(xb[k][q] & 0xffff0000u); }
#pragma unroll
        for (int j = 0; j < 8; ++j) ss += x1[j] * x1[j] + x2[j] * x2[j];
        ss += __shfl_xor(ss, 1); ss += __shfl_xor(ss, 2);
        if (isD) { const float rstd = __builtin_amdgcn_rsqf(ss * (1.f / 64.f) + EPS);
#pragma unroll
            for (int j = 0; j < 8; ++j) { x1[j] *= rstd * g1[j >> 2][j & 3]; x2[j] *= rstd * g2[j >> 2][j & 3]; } }
        u32x4 oa, ob;
#pragma unroll
        for (int q = 0; q < 4; ++q) { const float c0 = rp[k][q][0], s0 = rp[k][q][1], c1 = rp[k][q][2], s1 = rp[k][q][3];
            oa[q] = cvt_pk_bf16((x1[2 * q] * c0 - x2[2 * q] * s0) * sc, (x1[2 * q + 1] * c1 - x2[2 * q + 1] * s1) * sc);
            ob[q] = cvt_pk_bf16((x2[2 * q] * c0 + x1[2 * q] * s0) * sc, (x2[2 * q + 1] * c1 + x1[2 * q + 1] * s1) * sc); }
        if (active) {
            if (isC) { bf16_t* kc = KC + (size_t)tok * 384 + 64 + c * 8;
#pragma unroll
                for (int hh = 0; hh < 4; ++hh) { *(u32x4*)(kc + hh * 96) = oa; *(u32x4*)(kc + hh * 96 + 16) = ob; } }
            else { bf16_t* row = PROJ + (size_t)tok * PPITCH + e0; *(u32x4*)row = oa; *(u32x4*)(row + 16) = ob; } }
    }
}
__device__ __forceinline__ void pp_mla(int tok0, int hp, const bf16_t* PROJ, bf16_t* QC, bf16_t* KC, bf16_t* VC, const float2* rope, const bf16_t* WuqT, const bf16_t* WukvT, const float* cqn, const float* ckvn, int lane) {
    const int m = lane & 15, quad = lane >> 4, tok = tok0 + m, pos = tok & (SEQ - 1);
    const bf16_t* crow_ = PROJ + (size_t)tok * PPITCH + PC;
    bf16x8 aq[6], ak[4]; float ssq_ = 0.f, ssk_ = 0.f;
#pragma unroll
    for (int ks = 0; ks < 6; ++ks) aq[ks] = *(const bf16x8*)(crow_ + ks * 32 + quad * 8);
#pragma unroll
    for (int ks = 0; ks < 4; ++ks) ak[ks] = *(const bf16x8*)(crow_ + 192 + ks * 32 + quad * 8);
#pragma unroll
    for (int ks = 0; ks < 6; ++ks)
#pragma unroll
        for (int e = 0; e < 8; ++e) { const float x = bf2f((bf16_t)aq[ks][e]); ssq_ += x * x; }
#pragma unroll
    for (int ks = 0; ks < 4; ++ks)
#pragma unroll
        for (int e = 0; e < 8; ++e) { const float x = bf2f((bf16_t)ak[ks][e]); ssk_ += x * x; }
    ssq_ += __shfl_xor(ssq_, 16); ssq_ += __shfl_xor(ssq_, 32); ssk_ += __shfl_xor(ssk_, 16); ssk_ += __shfl_xor(ssk_, 32);
    const float rq = __builtin_amdgcn_rsqf(ssq_ * (1.f / 192.f) + EPS), rk = __builtin_amdgcn_rsqf(ssk_ * (1.f / 128.f) + EPS);
#pragma unroll
    for (int ks = 0; ks < 6; ++ks) { u32x4 w; const f32x4 ga = *(const f32x4*)(cqn + ks * 32 + quad * 8), gb = *(const f32x4*)(cqn + ks * 32 + quad * 8 + 4);
#pragma unroll
        for (int e = 0; e < 4; ++e) { const float g0 = e < 2 ? ga[2 * e] : gb[2 * e - 4], g1 = e < 2 ? ga[2 * e + 1] : gb[2 * e - 3]; w[e] = cvt_pk_bf16(bf2f((bf16_t)aq[ks][2 * e]) * rq * g0, bf2f((bf16_t)aq[ks][2 * e + 1]) * rq * g1); }
        aq[ks] = __builtin_bit_cast(bf16x8, w); }
#pragma unroll
    for (int ks = 0; ks < 4; ++ks) { u32x4 w; const f32x4 ga = *(const f32x4*)(ckvn + ks * 32 + quad * 8), gb = *(const f32x4*)(ckvn + ks * 32 + quad * 8 + 4);
#pragma unroll
        for (int e = 0; e < 4; ++e) { const float g0 = e < 2 ? ga[2 * e] : gb[2 * e - 4], g1 = e < 2 ? ga[2 * e + 1] : gb[2 * e - 3]; w[e] = cvt_pk_bf16(bf2f((bf16_t)ak[ks][2 * e]) * rk * g0, bf2f((bf16_t)ak[ks][2 * e + 1]) * rk * g1); }
        ak[ks] = __builtin_bit_cast(bf16x8, w); }
    const float qs = 0.10206207261596577f * LOG2E;
    f32x4 cs4[2];
#pragma unroll
    for (int q = 0; q < 2; ++q) cs4[q] = *(const f32x4*)(rope + pos * 16 + quad * 4 + 2 * q);
#pragma unroll 1
    for (int hi_ = 0; hi_ < 2; ++hi_) { const int hh = 2 * hp + hi_;
        {   f32x4 acc[6];
#pragma unroll
            for (int nt = 0; nt < 6; ++nt) { acc[nt] = (f32x4){0.f, 0.f, 0.f, 0.f}; const bf16_t* wr_ = WuqT + (size_t)((hh * 6 + nt) * 16 + m) * 192 + quad * 8;
#pragma unroll
                for (int ks = 0; ks < 6; ++ks) acc[nt] = MFMA16(*(const bf16x8*)(wr_ + ks * 32), aq[ks], acc[nt]); }
#pragma unroll
            for (int j = 0; j < 4; ++j) { const float c = cs4[j >> 1][2 * (j & 1)], sn = cs4[j >> 1][2 * (j & 1) + 1]; const float x1 = acc[4][j], x2 = acc[5][j]; acc[4][j] = x1 * c - x2 * sn; acc[5][j] = x2 * c + x1 * sn; }
            bf16_t* qo = QC + (size_t)tok * 384 + hh * 96 + quad * 4;
#pragma unroll
            for (int nt = 0; nt < 6; ++nt) { u32x2 w; w.x = cvt_pk_bf16(acc[nt][0] * qs, acc[nt][1] * qs); w.y = cvt_pk_bf16(acc[nt][2] * qs, acc[nt][3] * qs); *(u32x2*)(qo + nt * 16) = w; } }
        {   f32x4 acc[8];
#pragma unroll
            for (int nt = 0; nt < 8; ++nt) { acc[nt] = (f32x4){0.f, 0.f, 0.f, 0.f}; const bf16_t* wr_ = WukvT + (size_t)((hh * 8 + nt) * 16 + m) * 128 + quad * 8;
#pragma unroll
                for (int ks = 0; ks < 4; ++ks) acc[nt] = MFMA16(*(const bf16x8*)(wr_ + ks * 32), ak[ks], acc[nt]); }
            bf16_t* ko = KC + (size_t)tok * 384 + hh * 96 + quad * 4; bf16_t* vo = VC + (size_t)tok * 256 + hh * 64 + quad * 4;
#pragma unroll
            for (int nt = 0; nt < 4; ++nt) { u32x2 w; w.x = cvt_pk_bf16(acc[nt][0], acc[nt][1]); w.y = cvt_pk_bf16(acc[nt][2], acc[nt][3]); *(u32x2*)(ko + nt * 16) = w;
                u32x2 w2; w2.x = cvt_pk_bf16(acc[nt + 4][0], acc[nt + 4][1]); w2.y = cvt_pk_bf16(acc[nt + 4][2], acc[nt + 4][3]); *(u32x2*)(vo + nt * 16) = w2; } }
    }
}
__device__ __forceinline__ void pp_mla_lds(int tok0, int hh, const bf16_t* PROJ, bf16_t* QC, bf16_t* KC, bf16_t* VC, const float2* rope, const char* Lq, const char* Lkv, const float* cqn, const float* ckvn, int lane) {
    const int m = lane & 15, quad = lane >> 4, tok = tok0 + m, pos = tok & (SEQ - 1);
    const bf16_t* crow_ = PROJ + (size_t)tok * PPITCH + PC;
    bf16x8 aq[6], ak[4]; float ssq_ = 0.f, ssk_ = 0.f;
#pragma unroll
    for (int ks = 0; ks < 6; ++ks) aq[ks] = *(const bf16x8*)(crow_ + ks * 32 + quad * 8);
#pragma unroll
    for (int ks = 0; ks < 4; ++ks) ak[ks] = *(const bf16x8*)(crow_ + 192 + ks * 32 + quad * 8);
#pragma unroll
    for (int ks = 0; ks < 6; ++ks)
#pragma unroll
        for (int e = 0; e < 8; ++e) { const float x = bf2f((bf16_t)aq[ks][e]); ssq_ += x * x; }
#pragma unroll
    for (int ks = 0; ks < 4; ++ks)
#pragma unroll
        for (int e = 0; e < 8; ++e) { const float x = bf2f((bf16_t)ak[ks][e]); ssk_ += x * x; }
    ssq_ += __shfl_xor(ssq_, 16); ssq_ += __shfl_xor(ssq_, 32); ssk_ += __shfl_xor(ssk_, 16); ssk_ += __shfl_xor(ssk_, 32);
    const float rq = __builtin_amdgcn_rsqf(ssq_ * (1.f / 192.f) + EPS), rk = __builtin_amdgcn_rsqf(ssk_ * (1.f / 128.f) + EPS);
#pragma unroll
    for (int ks = 0; ks < 6; ++ks) { u32x4 w; const f32x4 ga = *(const f32x4*)(cqn + ks * 32 + quad * 8), gb = *(const f32x4*)(cqn + ks * 32 + quad * 8 + 4);
#pragma unroll
        for (int e = 0; e < 4; ++e) { const float g0 = e < 2 ? ga[2 * e] : gb[2 * e - 4], g1 = e < 2 ? ga[2 * e + 1] : gb[2 * e - 3]; w[e] = cvt_pk_bf16(bf2f((bf16_t)aq[ks][2 * e]) * rq * g0, bf2f((bf16_t)aq[ks][2 * e + 1]) * rq * g1); }
        aq[ks] = __builtin_bit_cast(bf16x8, w); }
#pragma unroll
    for (int ks = 0; ks < 4; ++ks) { u32x4 w; const f32x4 ga = *(const f32x4*)(ckvn + ks * 32 + quad * 8), gb = *(const f32x4*)(ckvn + ks * 32 + quad * 8 + 4);
#pragma unroll
        for (int e = 0; e < 4; ++e) { const float g0 = e < 2 ? ga[2 * e] : gb[2 * e - 4], g1 = e < 2 ? ga[2 * e + 1] : gb[2 * e - 3]; w[e] = cvt_pk_bf16(bf2f((bf16_t)ak[ks][2 * e]) * rk * g0, bf2f((bf16_t)ak[ks][2 * e + 1]) * rk * g1); }
        ak[ks] = __builtin_bit_cast(bf16x8, w); }
    const float qs = 0.10206207261596577f * LOG2E;
    f32x4 cs4[2];
#pragma unroll
    for (int q = 0; q < 2; ++q) cs4[q] = *(const f32x4*)(rope + pos * 16 + quad * 4 + 2 * q);
    {
        {   f32x4 acc[6];
#pragma unroll
            for (int nt = 0; nt < 6; ++nt) { acc[nt] = (f32x4){0.f, 0.f, 0.f, 0.f}; const char* wr_ = Lq + (nt * 16 + m) * 400 + quad * 16;
#pragma unroll
                for (int ks = 0; ks < 6; ++ks) acc[nt] = MFMA16(*(const bf16x8*)(wr_ + ks * 64), aq[ks], acc[nt]); }
#pragma unroll
            for (int j = 0; j < 4; ++j) { const float c = cs4[j >> 1][2 * (j & 1)], sn = cs4[j >> 1][2 * (j & 1) + 1]; const float x1 = acc[4][j], x2 = acc[5][j]; acc[4][j] = x1 * c - x2 * sn; acc[5][j] = x2 * c + x1 * sn; }
            bf16_t* qo = QC + (size_t)tok * 384 + hh * 96 + quad * 4;
#pragma unroll
            for (int nt = 0; nt < 6; ++nt) { u32x2 w; w.x = cvt_pk_bf16(acc[nt][0] * qs, acc[nt][1] * qs); w.y = cvt_pk_bf16(acc[nt][2] * qs, acc[nt][3] * qs); *(u32x2*)(qo + nt * 16) = w; } }
        {   f32x4 acc[8];
#pragma unroll
            for (int nt = 0; nt < 8; ++nt) { acc[nt] = (f32x4){0.f, 0.f, 0.f, 0.f}; const char* wr_ = Lkv + (nt * 16 + m) * 288 + quad * 16;
#pragma unroll
                for (int ks = 0; ks < 4; ++ks) acc[nt] = MFMA16(*(const bf16x8*)(wr_ + ks * 64), ak[ks], acc[nt]); }
            bf16_t* ko = KC + (size_t)tok * 384 + hh * 96 + quad * 4; bf16_t* vo = VC + (size_t)tok * 256 + hh * 64 + quad * 4;
#pragma unroll
            for (int nt = 0; nt < 4; ++nt) { u32x2 w; w.x = cvt_pk_bf16(acc[nt][0], acc[nt][1]); w.y = cvt_pk_bf16(acc[nt][2], acc[nt][3]); *(u32x2*)(ko + nt * 16) = w;
                u32x2 w2; w2.x = cvt_pk_bf16(acc[nt + 4][0], acc[nt + 4][1]); w2.y = cvt_pk_bf16(acc[nt + 4][2], acc[nt + 4][3]); *(u32x2*)(vo + nt * 16) = w2; } }
    }
}

template <int DQK, int NSUB, int MODE>
__device__ __forceinline__ void flash_unit(LAS char* L, const bf16_t* Qp, int qpitch, const bf16_t* Kp, int kpitch, const bf16_t* Vp, int vpitch,
                                           bf16_t* Op, int opitch, float lam, float oscale, const float* subln) {
    constexpr int KW = NSUB * DQK, KPB = KW * 2 + 16, VPB = 144, KBUF = 64 * KPB, VBUF = 64 * VPB, KCH = KW / 8, NKCH = 64 * KCH, ND0 = DQK / 16;
    constexpr int OFF_V = 2 * KBUF;
    const int tid = otid(), lane = tid & 63, wid = tid >> 6, r32 = lane & 31, hi = lane >> 5;
    char* Lg = (char*)L;
    bf16x8 qf[NSUB][ND0];
    { const bf16_t* qrow = Qp + (size_t)(32 * wid + r32) * qpitch;
#pragma unroll
      for (int s = 0; s < NSUB; ++s)
#pragma unroll
          for (int d0 = 0; d0 < ND0; ++d0) qf[s][d0] = *(const bf16x8*)(qrow + s * DQK + 16 * d0 + 8 * hi); }
    const int kr1 = tid / KCH, kc1 = tid % KCH, kr2 = (tid + 512) / KCH, kc2 = (tid + 512) % KCH; const bool has2 = (tid + 512) < NKCH;
    const int vr1 = tid >> 3, vc1 = tid & 7;
    const bf16_t* kg1 = Kp + (size_t)kr1 * kpitch + kc1 * 8; const bf16_t* kg2 = Kp + (size_t)kr2 * kpitch + kc2 * 8; const bf16_t* vg1 = Vp + (size_t)vr1 * vpitch + vc1 * 8;
    const int kl1 = kr1 * KPB + kc1 * 16, kl2 = kr2 * KPB + kc2 * 16, vl1 = vr1 * VPB + vc1 * 16;
    u32x4 rk1, rk2 = {0u, 0u, 0u, 0u}, rv1;
    float mref[NSUB], lrow[NSUB]; f32x16 o[NSUB][2], negm[NSUB];
#pragma unroll
    for (int s = 0; s < NSUB; ++s) { mref[s] = 0.f; lrow[s] = 0.f;
#pragma unroll
        for (int r = 0; r < 16; ++r) { o[s][0][r] = 0.f; o[s][1][r] = 0.f; negm[s][r] = 0.f; } }
    rk1 = *(const u32x4*)kg1; if (has2) rk2 = *(const u32x4*)kg2; rv1 = *(const u32x4*)vg1;
    __syncthreads();
    *(u32x4*)(Lg + kl1) = rk1; if (has2) *(u32x4*)(Lg + kl2) = rk2; *(u32x4*)(Lg + OFF_V + vl1) = rv1;
    __syncthreads();
    const int vq = (lane & 15) >> 2, vp_ = lane & 3, vblk = (lane >> 4) & 1;
    const int voff = (4 * hi + vq) * VPB + (16 * vblk + 4 * vp_) * 2;
    if (__builtin_amdgcn_readfirstlane(wid) >= 4) __builtin_amdgcn_s_setprio(1);
    for (int t = 0; t < SEQ / 64; ++t) {
        const int buf = t & 1;
        if (t + 1 < SEQ / 64) { const size_t ko = (size_t)(t + 1) * 64 * kpitch, vo = (size_t)(t + 1) * 64 * vpitch;
            rk1 = *(const u32x4*)(kg1 + ko); if (has2) rk2 = *(const u32x4*)(kg2 + ko); rv1 = *(const u32x4*)(vg1 + vo); }
        const char* Kb = Lg + buf * KBUF; LAS const char* Vb = L + OFF_V + buf * VBUF + voff;
#pragma unroll
        for (int s = 0; s < NSUB; ++s) {
            f32x16 p0, p1;
#pragma unroll
            for (int d0 = 0; d0 < ND0; ++d0) { const bf16x8 k0 = *(const bf16x8*)(Kb + r32 * KPB + (s * DQK + 16 * d0 + 8 * hi) * 2); const bf16x8 k1 = *(const bf16x8*)(Kb + (32 + r32) * KPB + (s * DQK + 16 * d0 + 8 * hi) * 2);
                if (d0 == 0) { p0 = MFMA32(k0, qf[s][d0], negm[s]); p1 = MFMA32(k1, qf[s][d0], negm[s]); }
                else { p0 = MFMA32(k0, qf[s][d0], p0); p1 = MFMA32(k1, qf[s][d0], p1); } }
#pragma unroll
            for (int hf = 0; hf < 2; ++hf) {
                f32x16& ph = hf ? p1 : p0;
                float mx = fmaxf(ph[0], ph[1]);
#pragma unroll
                for (int r = 2; r < 16; ++r) mx = fmaxf(mx, ph[r]);
                mx = fmaxf(mx, __shfl_xor(mx, 32));
                const bool first = (t == 0) && (hf == 0);
                if (first || __any(mx > 8.0f)) {
                    const float dl = first ? mx : fmaxf(mx, 0.f); mref[s] += dl;
#pragma unroll
                    for (int r = 0; r < 16; ++r) { ph[r] -= dl; negm[s][r] = -mref[s]; }
                    if (hf == 0) {
#pragma unroll
                        for (int r = 0; r < 16; ++r) p1[r] -= dl;
                    }
                    if (!first) { const float alpha = __builtin_amdgcn_exp2f(-dl); lrow[s] *= alpha;
#pragma unroll
                        for (int r = 0; r < 16; ++r) { o[s][0][r] *= alpha; o[s][1][r] *= alpha; } }
                }
#pragma unroll
                for (int r = 0; r < 16; ++r) ph[r] = __builtin_amdgcn_exp2f(ph[r]);
                { typedef float f32x2_ __attribute__((ext_vector_type(2))); f32x2_ r2 = {ph[0], ph[1]};
#pragma unroll
                  for (int r = 2; r < 16; r += 2) r2 += (f32x2_){ph[r], ph[r + 1]};
                  lrow[s] += r2[0] + r2[1]; }
                bf16x8 pf[2];
#pragma unroll
                for (int k2 = 0; k2 < 2; ++k2) { u32x4 w;
#pragma unroll
                    for (int e = 0; e < 4; ++e) w[e] = cvt_pk_bf16(ph[8 * k2 + 2 * e], ph[8 * k2 + 2 * e + 1]);
                    pf[k2] = __builtin_bit_cast(bf16x8, w); }
#pragma unroll
                for (int db = 0; db < 2; ++db)
#pragma unroll
                    for (int k2 = 0; k2 < 2; ++k2) { const int ks = 2 * hf + k2; const v4i16_t lo = vtr(Vb + (16 * ks) * VPB + db * 64), hh = vtr(Vb + (16 * ks + 8) * VPB + db * 64);
                        const bf16x8 vf = {lo[0], lo[1], lo[2], lo[3], hh[0], hh[1], hh[2], hh[3]};
                        o[s][db] = MFMA32(vf, pf[k2], o[s][db]); }
            }
        }
        if (t + 1 < SEQ / 64) { char* Kn = Lg + (buf ^ 1) * KBUF; *(u32x4*)(Kn + kl1) = rk1; if (has2) *(u32x4*)(Kn + kl2) = rk2; *(u32x4*)(Lg + OFF_V + (buf ^ 1) * VBUF + vl1) = rv1; }
        __syncthreads();
    }
    __builtin_amdgcn_s_setprio(0);
    bf16_t* orow = Op + (size_t)(32 * wid + r32) * opitch;
    if (MODE == 0) {
        const float inv = 1.0f / (lrow[0] + __shfl_xor(lrow[0], 32));
#pragma unroll
        for (int db = 0; db < 2; ++db)
#pragma unroll
            for (int g = 0; g < 4; ++g) { u32x2 w; w.x = cvt_pk_bf16(o[0][db][4 * g] * inv, o[0][db][4 * g + 1] * inv); w.y = cvt_pk_bf16(o[0][db][4 * g + 2] * inv, o[0][db][4 * g + 3] * inv);
                *(u32x2*)(orow + 32 * db + 8 * g + 4 * hi) = w; }
    } else {
        const float i1 = 1.0f / (lrow[0] + __shfl_xor(lrow[0], 32)), i2 = lam / (lrow[NSUB - 1] + __shfl_xor(lrow[NSUB - 1], 32));
        float ss = 0.f;
#pragma unroll
        for (int db = 0; db < 2; ++db)
#pragma unroll
            for (int r = 0; r < 16; ++r) { const float v = o[0][db][r] * i1 - o[NSUB - 1][db][r] * i2; o[0][db][r] = v; ss += v * v; }
        ss += __shfl_xor(ss, 32);
        const float rn = oscale / sqrtf(ss * (1.f / 64.f) + EPS);
#pragma unroll
        for (int db = 0; db < 2; ++db)
#pragma unroll
            for (int g = 0; g < 4; ++g) { const int d = 32 * db + 8 * g + 4 * hi; const f32x4 sg = *(const f32x4*)(subln + d);
                u32x2 w; w.x = cvt_pk_bf16(o[0][db][4 * g] * rn * sg[0], o[0][db][4 * g + 1] * rn * sg[1]); w.y = cvt_pk_bf16(o[0][db][4 * g + 2] * rn * sg[2], o[0][db][4 * g + 3] * rn * sg[3]);
                *(u32x2*)(orow + d) = w; }
    }
}

__device__ __forceinline__ void natten_unit(LAS char* L, const bf16_t* Pseq  , bf16_t* Oseq  , int h, int r0, const float* rpb) {
    constexpr int VPB = 144, OFF_RPB = 11 * 64 * VPB;
    const int tid = otid(), lane = tid & 63, wid = tid >> 6, m = lane & 15, quad = lane >> 4;
    char* Lg = (char*)L; float* rpbL = (float*)(Lg + OFF_RPB);
    int rs_lo = r0 - 4; rs_lo = rs_lo < 0 ? 0 : (rs_lo > 24 ? 24 : rs_lo);
    int rs_hi = r0 + 3 - 4; rs_hi = rs_hi < 0 ? 0 : (rs_hi > 24 ? 24 : rs_hi);
    const int nst = (rs_hi - rs_lo + 8) * 64 * 8;
    __syncthreads();
    {   const bf16_t* vsrc = Pseq + (size_t)(rs_lo * 64) * PPITCH + PB + 512 + h * 64;
#pragma unroll
        for (int i = 0; i < 11; ++i) { const int c = tid + 512 * i; if (c < nst) { const int row = c >> 3, ch = c & 7; *(u32x4*)(Lg + row * VPB + ch * 16) = *(const u32x4*)(vsrc + (size_t)row * PPITCH + ch * 8); } }
        if (tid < 465) rpbL[tid] = rpb[h * 465 + tid] * LOG2E;
    }
    __syncthreads();
#pragma unroll 1
    for (int it = 0; it < 2; ++it) {
        const int item = wid + 8 * it, r = r0 + (item >> 2), n = item & 3;
        int rs = r - 4; rs = rs < 0 ? 0 : (rs > 24 ? 24 : rs);
        int cb = 16 * n - 8; cb = cb < 0 ? 0 : (cb > 32 ? 32 : cb);
        const int qcol = 16 * n + m; int cs = qcol - 8; cs = cs < 0 ? 0 : (cs > 48 ? 48 : cs);
        const bf16_t* qrow = Pseq + (size_t)(r * 64 + qcol) * PPITCH + PB + h * 64 + quad * 8;
        const bf16x8 qf0 = *(const bf16x8*)qrow, qf1 = *(const bf16x8*)(qrow + 32);
        f32x4 sc[16];
#pragma unroll
        for (int t = 0; t < 16; ++t) { const int kr = t >> 1, kc0 = (t & 1) * 16;
            const bf16_t* krow = Pseq + (size_t)((rs + kr) * 64 + cb + kc0 + m) * PPITCH + PB + 256 + h * 64 + quad * 8;
            const bf16x8 k0 = *(const bf16x8*)krow, k1 = *(const bf16x8*)(krow + 32);
            f32x4 a = {0.f, 0.f, 0.f, 0.f}; a = MFMA16(k0, qf0, a); a = MFMA16(k1, qf1, a);
            const int dr = rs + kr - r + 7;
#pragma unroll
            for (int j = 0; j < 4; ++j) { const int kcol = cb + kc0 + 4 * quad + j; const bool ok = (kcol >= cs) && (kcol < cs + 16); int dc = kcol - qcol + 15; dc = dc < 0 ? 0 : (dc > 30 ? 30 : dc);
                a[j] = ok ? a[j] + rpbL[dr * 31 + dc] : -INFINITY; }
            sc[t] = a; }
        float mx = -INFINITY;
#pragma unroll
        for (int t = 0; t < 16; ++t) mx = fmaxf(mx, fmaxf(fmaxf(sc[t][0], sc[t][1]), fmaxf(sc[t][2], sc[t][3])));
        mx = fmaxf(mx, __shfl_xor(mx, 16)); mx = fmaxf(mx, __shfl_xor(mx, 32));
        float sum = 0.f;
#pragma unroll
        for (int t = 0; t < 16; ++t)
#pragma unroll
            for (int j = 0; j < 4; ++j) { const float e = __builtin_amdgcn_exp2f(sc[t][j] - mx); sc[t][j] = e; sum += e; }
        sum += __shfl_xor(sum, 16); sum += __shfl_xor(sum, 32);
        const float inv = 1.0f / sum;
        f32x4 o[4];
#pragma unroll
        for (int dt = 0; dt < 4; ++dt) o[dt] = (f32x4){0.f, 0.f, 0.f, 0.f};
        LAS const char* Vb = L + (size_t)((rs - rs_lo) * 64 + cb + 4 * quad + (m >> 2)) * VPB + (lane & 3) * 8;
#pragma unroll
        for (int u = 0; u < 8; ++u) { u32x4 w; w.x = cvt_pk_bf16(sc[2 * u][0], sc[2 * u][1]); w.y = cvt_pk_bf16(sc[2 * u][2], sc[2 * u][3]);
            w.z = cvt_pk_bf16(sc[2 * u + 1][0], sc[2 * u + 1][1]); w.w = cvt_pk_bf16(sc[2 * u + 1][2], sc[2 * u + 1][3]);
            const bf16x8 pf = __builtin_bit_cast(bf16x8, w);
#pragma unroll
            for (int dt = 0; dt < 4; ++dt) { const v4i16_t lo = vtr(Vb + (u * 64) * VPB + dt * 32), hh = vtr(Vb + (u * 64 + 16) * VPB + dt * 32);
                const bf16x8 vf = {lo[0], lo[1], lo[2], lo[3], hh[0], hh[1], hh[2], hh[3]};
                o[dt] = MFMA16(vf, pf, o[dt]); } }
        bf16_t* orow = Oseq + (size_t)(r * 64 + qcol) * 256 + h * 64 + 4 * quad;
#pragma unroll
        for (int dt = 0; dt < 4; ++dt) { u32x2 w; w.x = cvt_pk_bf16(o[dt][0] * inv, o[dt][1] * inv); w.y = cvt_pk_bf16(o[dt][2] * inv, o[dt][3] * inv); *(u32x2*)(orow + dt * 16) = w; }
    }
}

#define XB_TMO      128
#define XB_XCNT(j)  (256  + 64 * (j))
#define XB_XSUB(j)  (1280 + 64 * (j))
#define XB_XGEN(j)  (2304 + 64 * (j))
#define XB_TOP      3328
#define XB_TOPGEN   3392
#define XCD_BAR_WORDS 3456
#define XB_SPIN_CAP (1u << 18)

__device__ __forceinline__ unsigned xb_ld(unsigned* p)              { return __hip_atomic_load(p, __ATOMIC_RELAXED, __HIP_MEMORY_SCOPE_AGENT); }
__device__ __forceinline__ unsigned xb_add(unsigned* p, unsigned v) { return __hip_atomic_fetch_add(p, v, __ATOMIC_RELAXED, __HIP_MEMORY_SCOPE_AGENT); }
__device__ __forceinline__ unsigned xb_xcc_id() { return (unsigned)__builtin_amdgcn_s_getreg((3 << 11) | 20) & 0xFu; }
#define XB_SPIN(cond, bar) do { unsigned _sp = 0; while (cond) { __builtin_amdgcn_s_sleep(1); \
    if ((++_sp & 255u) == 0u) { if (xb_ld(&(bar)[XB_TMO])) break; if (_sp > XB_SPIN_CAP) { atomicAdd(&(bar)[XB_TMO], 1u); break; } } } } while (0)

struct XcdBarrier {
    unsigned* bar; unsigned x;
    volatile LAS unsigned* st;
};

__device__ __forceinline__ XcdBarrier xcd_barrier_post(unsigned* bar, volatile LAS unsigned* st) {
    XcdBarrier b; b.bar = bar; b.x = xb_xcc_id(); b.st = st;
    if (threadIdx.x == 0) (void)xb_add(&bar[XB_XCNT(b.x)], 1u);
    return b;
}
__device__ __forceinline__ void xcd_barrier_complete(unsigned* bar, unsigned x, unsigned& nloc, unsigned& nx) {
    const unsigned G = gridDim.x * gridDim.y * gridDim.z;
    unsigned sum, cnt, mine, sp = 0u;
    for (;;) {
        sum = 0u; cnt = 0u; mine = 0u;
#pragma unroll
        for (unsigned j = 0; j < 16; ++j) { const unsigned c = xb_ld(&bar[XB_XCNT(j)]); sum += c; cnt += (c > 0u) ? 1u : 0u; mine = (j == x) ? c : mine; }
        if (sum == G) break;
        __builtin_amdgcn_s_sleep(1);
        if ((++sp & 255u) == 0u) { if (xb_ld(&bar[XB_TMO])) break; if (sp > XB_SPIN_CAP) { atomicAdd(&bar[XB_TMO], 1u); break; } }
    }
    nloc = mine > 0u ? mine : 1u; nx = cnt > 0u ? cnt : 1u;
}

__device__ __forceinline__ void xcd_barrier(const XcdBarrier& b) {
    asm volatile("s_waitcnt vmcnt(0)" ::: "memory");
    __syncthreads();
    if (threadIdx.x == 0) {
        unsigned* bar = b.bar;
        __builtin_amdgcn_s_waitcnt(0);
        unsigned nloc = b.st[0], nx = b.st[1];
        if (nloc == 0u) { xcd_barrier_complete(bar, b.x, nloc, nx); b.st[0] = nloc; b.st[1] = nx; }
        const unsigned old = xb_add(&bar[XB_XSUB(b.x)], 1u);
        const unsigned gen = old / nloc;
        if (old + 1u == (gen + 1u) * nloc) {
            __builtin_amdgcn_fence(__ATOMIC_RELEASE, "agent");
            asm volatile("s_waitcnt vmcnt(0)" ::: "memory");
            const unsigned og = xb_add(&bar[XB_TOP], 1u);
            const unsigned tg = og / nx;
            if (og + 1u == (tg + 1u) * nx) xb_add(&bar[XB_TOPGEN], 1u);
            else XB_SPIN(xb_ld(&bar[XB_TOPGEN]) == tg, bar);
            __builtin_amdgcn_fence(__ATOMIC_ACQUIRE, "agent");
            xb_add(&bar[XB_XGEN(b.x)], 1u);
            asm volatile("s_waitcnt vmcnt(0)" ::: "memory");
        } else {
            XB_SPIN(xb_ld(&bar[XB_XGEN(b.x)]) == gen, bar);
            __builtin_amdgcn_fence(__ATOMIC_ACQUIRE, "agent");
            asm volatile("s_waitcnt vmcnt(0)" ::: "memory");
        }
    }
    __syncthreads();
}

__global__ void __launch_bounds__(NTHR, 2) mega_fwd(Args a) {
    extern __shared__ __attribute__((aligned(16))) unsigned char lds_raw[];
    cg::grid_group grid = cg::this_grid();
    LAS unsigned char* lds = (LAS unsigned char*)lds_raw;
    const int G = gridDim.x, bx = blockIdx.x;
    const int vcu = (G % 8 == 0) ? (bx % 8) * (G / 8) + bx / 8 : bx;
    const int NGW = G * NWAVES, NT = G * NTHR;
#define TIDS() const int tid = otid(), lane = tid & 63, wave = __builtin_amdgcn_readfirstlane(tid >> 6), gw = vcu * NWAVES + wave, gtid = vcu * NTHR + tid; (void)lane; (void)gw; (void)gtid
#define WSP(name) unsigned char* name = a.ws; asm volatile("" : "+s"(name))

    volatile LAS unsigned* MISC = (volatile LAS unsigned*)(lds + 133120);
    if (otid() < 32) MISC[otid()] = 0u;
    __syncthreads();
    XcdBarrier bar = xcd_barrier_post((unsigned*)a.ws, MISC + 8);
#define GSYNC() xcd_barrier(bar)
    PH(0) { WSP(w); TIDS(); prologue(a, w, (char*)lds_raw, gw, NGW, wave, lane); }
    grid.sync();

#pragma unroll 1
    for (int g = 0; g < NGROUP; ++g) {
#pragma unroll 1
        for (int l = 0; l < DEPTH; ++l) {
            int row_g0 = g * TMAX, T = (g < 2) ? TMAX : (NTOK - 2 * TMAX); asm volatile("" : "+s"(row_g0), "+s"(T));
            if (l == 0) {
                PH(1) { WSP(w); TIDS(); convert_phase(a.in[0], a.in[1], row_g0, T, (bf16_t*)(w + WS_XN), (float*)(w + WS_MRG), gw, NGW, lane); }
                GSYNC();
            }
            PH(2) { WSP(w); pg8::Gemm gm{(const bf16_t*)(w + WS_XN), (const bf16_t*)(w + WS_WIN) + (size_t)l * NPROJ * DM, T, NPROJ, DM}; pg8::StaticOrder S; S.init(T, NPROJ, G, bx); pg8::EpiProj E{(bf16_t*)(w + WS_PROJ), PPITCH, PG / 256, (const float*)(w + WS_MRG), (bf16_t*)(w + WS_RAT), T};
              pg8::gemm_phase<pg8::EpiProj, pg8::StaticOrder, true, true>(lds, gm, S, E); }
            GSYNC();
            PH(3) { WSP(w); TIDS(); bf16_t* PROJ = (bf16_t*)(w + WS_PROJ);
                bf16_t* KC = (bf16_t*)(w + WS_KC); const float2* rope = (const float2*)(w + WS_ROPE);
#pragma unroll 1
                for (int t0 = gw; t0 < T; t0 += 2 * NGW) { if (t0 + NGW < T) { const int tk[2] = {t0, t0 + NGW}; pp_elem<2>(tk, PROJ, KC, rope, a.in[14] + l * 64, a.in[15] + l * 64, lane); }
                                                          else { const int tk[1] = {t0}; pp_elem<1>(tk, PROJ, KC, rope, a.in[14] + l * 64, a.in[15] + l * 64, lane); } }
                }
#pragma unroll 1
                for (int hh = 0; hh < 4; ++hh) { WSP(w2); TIDS(); char* Lw = (char*)lds_raw;
                    const bf16_t* Wq_ = (const bf16_t*)(w2 + WS_WUQ) + (size_t)l * 384 * 192 + (size_t)hh * 96 * 192; const bf16_t* Wkv_ = (const bf16_t*)(w2 + WS_WUKV) + (size_t)l * 512 * 128 + (size_t)hh * 128 * 128;
                    __syncthreads();
#pragma unroll
                    for (int i_ = 0; i_ < 9; ++i_) { const int c = tid + 512 * i_;
                        if (c < 2304) { const int row = c / 24, ch = c - row * 24; *(u32x4*)(Lw + row * 400 + ch * 16) = *(const u32x4*)(Wq_ + row * 192 + ch * 8); }
                        else if (c < 4352) { const int c2 = c - 2304, row = c2 >> 4, ch = c2 & 15; *(u32x4*)(Lw + 38400 + row * 288 + ch * 16) = *(const u32x4*)(Wkv_ + row * 128 + ch * 8); } }
                    __syncthreads();
#pragma unroll 1
                    for (int tl = wave * G + vcu; tl < T / 16; tl += NGW) pp_mla_lds(tl * 16, hh, (const bf16_t*)(w2 + WS_PROJ), (bf16_t*)(w2 + WS_QC), (bf16_t*)(w2 + WS_KC), (bf16_t*)(w2 + WS_VC), (const float2*)(w2 + WS_ROPE), Lw, Lw + 38400, a.in[10] + l * 192, a.in[11] + l * 128, lane);
                }
            GSYNC();
            PH(4) {
                const float lam_init = (l == 0) ? 0.2f : (0.8f - 0.6f * 0.7408182206817179f);
                const int NU_F = (T >> 11) * 4 * 8, NU_B = (T >> 11) * 4 * 8;
                if (FLK & 1) {
                    float s1 = 0.f, s2 = 0.f;
                    for (int i = 0; i < 32; ++i) { s1 += a.in[4][l * 32 + i] * a.in[5][l * 32 + i]; s2 += a.in[6][l * 32 + i] * a.in[7][l * 32 + i]; }
                    const float lam = expf(s1) - expf(s2) + lam_init;
#pragma unroll 1
                    for (int uu = vcu; uu < NU_F; uu += G) { WSP(w); bf16_t* PROJ = (bf16_t*)(w + WS_PROJ); bf16_t* OB = (bf16_t*)(w + WS_OB);
                        const int b = uu >> 5, h = (uu >> 3) & 3, qb = uu & 7; const size_t sb = (size_t)b * SEQ, q0 = sb + (size_t)qb * 256;
                        flash_unit<32, 2, 1>((LAS char*)lds, PROJ + q0 * PPITCH + PA + h * 64, PPITCH, PROJ + sb * PPITCH + PA + 256 + h * 64, PPITCH, PROJ + sb * PPITCH + PA + 512 + h * 64, PPITCH,
                                             OB + q0 * 256 + h * 64, 256, lam, 1.0f - lam_init, a.in[8] + l * 64); } }
                if (FLK & 2) {
#pragma unroll 1
                    for (int uu = vcu; uu < NU_F; uu += G) { WSP(w); bf16_t* QC = (bf16_t*)(w + WS_QC); bf16_t* KC = (bf16_t*)(w + WS_KC); bf16_t* VC = (bf16_t*)(w + WS_VC); bf16_t* OB = (bf16_t*)(w + WS_OB);
                        const int b = uu >> 5, h = (uu >> 3) & 3, qb = uu & 7; const size_t sb = (size_t)b * SEQ, q0 = sb + (size_t)qb * 256;
                        flash_unit<96, 1, 0>((LAS char*)lds, QC + q0 * 384 + h * 96, 384, KC + sb * 384 + h * 96, 384, VC + sb * 256 + h * 64, 256,
                                             OB + (size_t)2 * T * 256 + q0 * 256 + h * 64, 256, 0.f, 1.f, nullptr); } }
                if (FLK & 4) {
#pragma unroll 1
                    for (int uu = vcu; uu < NU_F; uu += G) { WSP(w); bf16_t* PROJ = (bf16_t*)(w + WS_PROJ); bf16_t* OB = (bf16_t*)(w + WS_OB);
                        const int b = uu >> 5, h = (uu >> 3) & 3, qb = uu & 7; const size_t sb = (size_t)b * SEQ, q0 = sb + (size_t)qb * 256;
                        flash_unit<64, 1, 0>((LAS char*)lds, PROJ + q0 * PPITCH + PD + h * 64, PPITCH, PROJ + sb * PPITCH + PD + 256 + (h >> 1) * 64, PPITCH, PROJ + sb * PPITCH + PD + 384 + (h >> 1) * 64, PPITCH,
                                             OB + (size_t)3 * T * 256 + q0 * 256 + h * 64, 256, 0.f, 1.f, nullptr); } }
                if (FLK & 8) {
#pragma unroll 1
                    for (int uu = vcu; uu < NU_B; uu += G) { WSP(w); bf16_t* PROJ = (bf16_t*)(w + WS_PROJ); bf16_t* OB = (bf16_t*)(w + WS_OB);
                        const int b = uu >> 5, h = (uu >> 3) & 3, r0 = (uu & 7) * 4;
                        natten_unit((LAS char*)lds, PROJ + (size_t)b * SEQ * PPITCH, OB + (size_t)1 * T * 256 + (size_t)b * SEQ * 256, h, r0, a.in[9] + l * 4 * 465); } }
            }
            GSYNC();
            PH(5) { WSP(w); pg8::Gemm gm{(const bf16_t*)(w + WS_OB), (const bf16_t*)(w + WS_WBR) + (size_t)l * 4 * 1024 * 256, 4 * T, 4096, 256}; pg8::BranchOrder S{T / 256, G, bx};
              pg8::EpiBranch E{(const bf16_t*)(w + WS_RAT), T, (bf16_t*)(w + WS_MB), T / 256};
              pg8::gemm_phase<pg8::EpiBranch, pg8::BranchOrder, true, true>(lds, gm, S, E); }
            GSYNC();
            PH(6) { WSP(w); pg8::Gemm gm{(const bf16_t*)(w + WS_MB), (const bf16_t*)(w + WS_WOUT) + (size_t)l * DM * DM, T, DM, DM}; asm volatile("" : "+s"(gm.A), "+s"(gm.Bt)); pg8::StaticOrder S; S.init(T, DM, G, bx);
              pg8::EpiResid E{(bf16_t*)(w + WS_XN), (float*)(w + WS_MRG) + 16 * TMAX};
              pg8::gemm_phase<pg8::EpiResid, pg8::StaticOrder, true, true>(lds, gm, S, E); }
            GSYNC();
            PH(8) { WSP(w); pg8::Gemm gm{(const bf16_t*)(w + WS_XN), (const bf16_t*)(w + WS_WFI) + (size_t)l * NUG * DM, T, NUG, DM}; asm volatile("" : "+s"(gm.A), "+s"(gm.Bt)); pg8::StaticOrder S; S.init(T, NUG, G, bx);
              pg8::EpiFfn E{(bf16_t*)(w + WS_ACT), (float*)(w + WS_MRG) + 64 * TMAX, (const float*)(w + WS_MRG) + 16 * TMAX, a.in[20] + (size_t)l * 3 * FF, a.in[21] + (size_t)l * FF, T / 64};
              pg8::gemm_phase<pg8::EpiFfn, pg8::StaticOrder, true, true>(lds, gm, S, E); }
            GSYNC();
            PH(9) { WSP(w); TIDS(); conv_fix_phase((const float*)(w + WS_MRG) + 64 * TMAX, (bf16_t*)(w + WS_ACT), a.in[20] + (size_t)l * 3 * FF, T, gtid, NT); }
            GSYNC();
            PH(10) { WSP(w); pg8::Gemm gm{(const bf16_t*)(w + WS_ACT), (const bf16_t*)(w + WS_WFO) + (size_t)l * DM * FF, T, DM, FF}; asm volatile("" : "+s"(gm.A), "+s"(gm.Bt)); pg8::StaticOrder S; S.init(T, DM, G, bx);
              pg8::EpiResid E{(bf16_t*)(w + WS_XN), (float*)(w + WS_MRG)};
              pg8::gemm_phase<pg8::EpiResid, pg8::StaticOrder, true, true>(lds, gm, S, E); }
            GSYNC();
            PH(11) { WSP(w); TIDS(); if (l == DEPTH - 1) final_norm_phase(a.out, row_g0, T, (const bf16_t*)(w + WS_XN), (const float*)(w + WS_MRG), a.in[23], gw, NGW, lane); }
            if (l == DEPTH - 1) GSYNC();
        }
    }
}

extern "C" void kernel_launch(void* const* d_in, const int* in_sizes, int n_in, void* d_out, int out_size, void* d_ws, size_t ws_size, hipStream_t stream) {
    static int grid = 0;
    if (grid == 0) {
        if (n_in != 24 || out_size != NTOK * DM || ws_size < WS_END) { fprintf(stderr, "kernel_launch: unexpected shapes (n_in %d, out %d, ws %zu)\n", n_in, out_size, ws_size); grid = -1; return; }
        int dev = 0, cus = 0, per_cu = 0;
        if (hipGetDevice(&dev) != hipSuccess || hipDeviceGetAttribute(&cus, hipDeviceAttributeMultiprocessorCount, dev) != hipSuccess) { grid = -1; return; }
        if (hipFuncSetAttribute((const void*)mega_fwd, hipFuncAttributeMaxDynamicSharedMemorySize, LDS_BYTES) != hipSuccess) { fprintf(stderr, "kernel_launch: hipFuncSetAttribute failed\n"); grid = -1; return; }
        if (hipOccupancyMaxActiveBlocksPerMultiprocessor(&per_cu, (const void*)mega_fwd, NTHR, LDS_BYTES) != hipSuccess || per_cu < 1) { fprintf(stderr, "kernel_launch: occupancy query says %d\n", per_cu); per_cu = 1; }
        (void)hipGetLastError();
        grid = cus * per_cu;
    }
    if (grid < 0) return;
    if (hipMemsetAsync(d_ws, 0, 16384, stream) != hipSuccess) { fprintf(stderr, "kernel_launch: memset of barrier words failed\n"); return; }
    Args a{};
    for (int i = 0; i < 24; ++i) a.in[i] = (const float*)d_in[i];
    a.out = (float*)d_out; a.ws = (unsigned char*)d_ws;
    void* args[] = {&a};
    hipError_t e = hipLaunchCooperativeKernel((const void*)mega_fwd, dim3(grid), dim3(NTHR), args, LDS_BYTES, stream);
    if (e != hipSuccess) fprintf(stderr, "kernel_launch: cooperative launch failed: %s (grid %d)\n", hipGetErrorString(e), grid);
}
```
